# Optimizing an MI355X kernel written in HIP

```python
import math
import jax, jax.numpy as jnp
from jax import lax
import numpy as np


D_MODEL = 1024
BATCH = 4
SEQ = 8192
DEPTH = 2

PLE_DIM = 256
DA_HEADS = 4
DA_QK_DIM = 64
DA_V_DIM = 128
DA_WIDTH = DA_HEADS * DA_V_DIM
RET_HEADS = 4
RET_HEAD_DIM = 64
RET_WIDTH = RET_HEADS * RET_HEAD_DIM
RET_CHUNK = 128
S5_WIDTH = 256
S5_GROUP = 16
S5_GROUPS = S5_WIDTH // S5_GROUP
S5_STATE = 64
MIX_WIDTH = DA_WIDTH + RET_WIDTH + S5_WIDTH
D_FF = 2816
CONV_WIDTH = 3
ROPE_THETA = 10000.0
Q_BLOCK = 128
LN_EPS = 1e-5
ALPHA = (2 * DEPTH) ** 0.25
BETA = (8 * DEPTH) ** -0.25

COL_DA_Q = 0
COL_DA_K = COL_DA_Q + DA_HEADS * 2 * DA_QK_DIM
COL_DA_V = COL_DA_K + DA_HEADS * 2 * DA_QK_DIM
COL_RET_Q = COL_DA_V + DA_WIDTH
COL_RET_K = COL_RET_Q + RET_WIDTH
COL_RET_V = COL_RET_K + RET_WIDTH
COL_RET_G = COL_RET_V + RET_WIDTH
COL_S5_U = COL_RET_G + RET_WIDTH
IN_COLS = COL_S5_U + S5_WIDTH

kernel_name = 'hybrid_diffattn_s5_retention_encoder'

F32 = jnp.float32


def layer_norm(x, g, b):
    xf = x.astype(F32)
    mu = jnp.mean(xf, axis=-1, keepdims=True)
    var = jnp.mean(jnp.square(xf - mu), axis=-1, keepdims=True)
    y = (xf - mu) * lax.rsqrt(var + LN_EPS)
    return (y * g.astype(F32) + b.astype(F32)).astype(x.dtype)


def rms_norm(x, g, eps=1e-6):
    xf = x.astype(F32)
    y = xf * lax.rsqrt(jnp.mean(jnp.square(xf), axis=-1, keepdims=True) + eps)
    return (y * g.astype(F32)).astype(x.dtype)


def rope_tables(positions, dim):
    inv_freq = ROPE_THETA ** (-jnp.arange(0, dim, 2, dtype=F32) / dim)
    ang = positions.astype(F32)[..., None] * inv_freq
    return jnp.cos(ang), jnp.sin(ang)


def apply_rope(x, cos, sin):
    extra = x.ndim - 3
    shp = cos.shape[:2] + (1,) * extra + cos.shape[-1:]
    c = cos.reshape(shp).astype(x.dtype)
    s = sin.reshape(shp).astype(x.dtype)
    x1, x2 = jnp.split(x, 2, axis=-1)
    return jnp.concatenate([x1 * c - x2 * s, x2 * c + x1 * s], axis=-1)


def diff_attention(q, k, v, cos, sin, lam, subln_g, lambda_init):
    Bsz, L, H, _, d = q.shape
    dv = v.shape[-1]
    nb = L // Q_BLOCK
    q = apply_rope(q, cos, sin) * (d ** -0.5)
    k = apply_rope(k, cos, sin)
    q_blocks = q.reshape(Bsz, nb, Q_BLOCK, H, 2, d).transpose(1, 0, 3, 4, 2, 5)
    k_t = k.transpose(0, 2, 3, 1, 4)
    v_t = v.transpose(0, 2, 1, 3)

    def attend(qb):
        s = jnp.einsum('bhmqd,bhmkd->bhmqk', qb, k_t).astype(F32)
        a = jax.nn.softmax(s, axis=-1)
        w = (a[:, :, 0] - lam * a[:, :, 1]).astype(v.dtype)
        return jnp.einsum('bhqk,bhkv->bhqv', w, v_t)

    o = lax.map(attend, q_blocks)
    o = o.transpose(1, 0, 3, 2, 4).reshape(Bsz, L, H, dv)
    o = rms_norm(o, subln_g) * (1.0 - lambda_init)
    return o.reshape(Bsz, L, H * dv)


def _retention_causal(q, k, v, log_gamma, include_diag):
    Bsz, L, H, d = q.shape
    dv = v.shape[-1]
    C = RET_CHUNK
    nc = L // C

    def chunks(t):
        return t.reshape(Bsz, nc, C, H, t.shape[-1]).transpose(1, 0, 3, 2, 4)

    qc, kc, vc = chunks(q), chunks(k), chunks(v)
    idx = jnp.arange(C, dtype=F32)
    diff = idx[:, None] - idx[None, :]
    mask = (diff >= 0) if include_diag else (diff > 0)
    lg = log_gamma[:, None, None]
    decay_in = jnp.where(mask[None], jnp.exp(lg * jnp.maximum(diff, 0.0)[None]), 0.0)
    s = jnp.einsum('nbhqd,nbhkd->nbhqk', qc, kc) * decay_in.astype(q.dtype)
    inner = jnp.einsum('nbhqk,nbhkv->nbhqv', s, vc)
    k_decay = jnp.exp(log_gamma[:, None] * (C - 1 - idx)[None]).astype(q.dtype)
    q_decay = jnp.exp(log_gamma[:, None] * (idx + 1)[None]).astype(q.dtype)
    chunk_decay = jnp.exp(log_gamma * C).astype(q.dtype)
    kv = jnp.einsum('nbhkd,nbhkv->nbhdv', kc * k_decay[:, :, None], vc)

    def step(state, kv_c):
        return chunk_decay[:, None, None] * state + kv_c, state

    _, state_before = lax.scan(step, jnp.zeros_like(kv[0]), kv)
    cross = jnp.einsum('nbhqd,nbhdv->nbhqv', qc * q_decay[:, :, None], state_before)
    return (inner + cross).transpose(1, 0, 3, 2, 4).reshape(Bsz, L, H, dv)


def retention_block(q, k, v, g, cos, sin, log_gamma, gn_g, gn_b):
    Bsz, L, H, d = q.shape
    q = apply_rope(q, cos, sin)
    k = apply_rope(k, cos, sin) * (d ** -0.5)
    fwd = _retention_causal(q, k, v, log_gamma, True)
    bwd = jnp.flip(_retention_causal(jnp.flip(q, 1), jnp.flip(k, 1), jnp.flip(v, 1), log_gamma, False), 1)
    o = layer_norm(fwd + bwd, gn_g, gn_b)
    return jax.nn.silu(g) * o.reshape(Bsz, L, H * v.shape[-1])


def _complex_linear_combine(left, right):
    ar1, ai1, br1, bi1 = left
    ar2, ai2, br2, bi2 = right
    ar = ar2 * ar1 - ai2 * ai1
    ai = ar2 * ai1 + ai2 * ar1
    br = ar2 * br1 - ai2 * bi1 + br2
    bi = ar2 * bi1 + ai2 * br1 + bi2
    return ar, ai, br, bi


def s5_block(u, A_re, A_im, log_dt, B_re, B_im, C_re, C_im, D, glu_w, glu_b):
    Bsz, L, _ = u.shape
    dt_ = u.dtype
    ug = u.reshape(Bsz, L, S5_GROUPS, S5_GROUP)
    y = D.reshape(S5_GROUPS, S5_GROUP).astype(dt_) * ug
    for direction in range(2):
        a_re = A_re[direction].astype(F32)
        a_im = A_im[direction].astype(F32)
        step = jnp.exp(log_dt[direction].astype(F32))[:, None]
        e = jnp.exp(step * a_re)
        abar_re = e * jnp.cos(step * a_im)
        abar_im = e * jnp.sin(step * a_im)
        den = a_re * a_re + a_im * a_im
        nr = abar_re - 1.0
        ni = abar_im
        coef_re = (nr * a_re + ni * a_im) / den
        coef_im = (ni * a_re - nr * a_im) / den
        b_re = B_re[direction].astype(F32)
        b_im = B_im[direction].astype(F32)
        bb_re = (coef_re[..., None] * b_re - coef_im[..., None] * b_im).astype(dt_)
        bb_im = (coef_re[..., None] * b_im + coef_im[..., None] * b_re).astype(dt_)
        bu_re = jnp.einsum('blgc,gpc->blgp', ug, bb_re)
        bu_im = jnp.einsum('blgc,gpc->blgp', ug, bb_im)
        a_seq_re = jnp.broadcast_to(abar_re.astype(dt_)[None, None], (1, L, S5_GROUPS, S5_STATE))
        a_seq_im = jnp.broadcast_to(abar_im.astype(dt_)[None, None], (1, L, S5_GROUPS, S5_STATE))
        _, _, x_re, x_im = lax.associative_scan(
            _complex_linear_combine, (a_seq_re, a_seq_im, bu_re, bu_im),
            reverse=(direction == 1), axis=1)
        y = y + jnp.einsum('blgp,gcp->blgc', x_re, C_re[direction].astype(dt_)) \
              - jnp.einsum('blgp,gcp->blgc', x_im, C_im[direction].astype(dt_))
    y = jax.nn.gelu(y.reshape(Bsz, L, S5_WIDTH))
    return y * jax.nn.sigmoid(y @ glu_w + glu_b)


def conv_ffn(x, w_up, conv_w, conv_b, w_down):
    h = x @ w_up
    gate, val = jnp.split(h, 2, axis=-1)
    pad = CONV_WIDTH // 2
    gate = lax.conv_general_dilated(
        gate, conv_w[:, None, :].astype(gate.dtype), window_strides=(1,),
        padding=((pad, pad),), dimension_numbers=('NWC', 'WIO', 'NWC'),
        feature_group_count=D_FF) + conv_b
    return (jax.nn.gelu(gate) * val) @ w_down


def setup_inputs(seed: int = 0) -> dict:
    key = jax.random.key(seed)
    ks = jax.random.split(key, 40)
    nrm = lambda k, shape, s: jax.random.normal(k, shape, F32) * s
    x = jax.random.normal(ks[0], (BATCH, SEQ, D_MODEL), F32)
    p = jax.random.normal(ks[1], (DEPTH, BATCH, SEQ, PLE_DIM), F32)
    positions = jnp.broadcast_to(jnp.arange(SEQ, dtype=jnp.int32)[None], (BATCH, SEQ))
    col_scale = jnp.ones((IN_COLS,), F32)
    col_scale = col_scale.at[COL_DA_V:COL_RET_Q].set(BETA).at[COL_RET_V:COL_RET_G].set(BETA)
    w_in = nrm(ks[2], (DEPTH, D_MODEL, IN_COLS), D_MODEL ** -0.5) * col_scale
    da_lambda_q1 = nrm(ks[3], (DEPTH, DA_QK_DIM), 0.1)
    da_lambda_k1 = nrm(ks[4], (DEPTH, DA_QK_DIM), 0.1)
    da_lambda_q2 = nrm(ks[5], (DEPTH, DA_QK_DIM), 0.1)
    da_lambda_k2 = nrm(ks[6], (DEPTH, DA_QK_DIM), 0.1)
    da_subln_g = 1.0 + nrm(ks[7], (DEPTH, DA_V_DIM), 0.02)
    ret_gn_g = 1.0 + nrm(ks[8], (DEPTH, RET_HEAD_DIM), 0.02)
    ret_gn_b = nrm(ks[9], (DEPTH, RET_HEAD_DIM), 0.02)
    n_idx = jnp.arange(S5_STATE, dtype=F32)
    s5_A_re = -0.5 + nrm(ks[10], (DEPTH, 2, S5_GROUPS, S5_STATE), 0.01)
    s5_A_im = math.pi * n_idx + nrm(ks[11], (DEPTH, 2, S5_GROUPS, S5_STATE), 0.01)
    s5_log_dt = jax.random.uniform(ks[12], (DEPTH, 2, S5_GROUPS), F32, math.log(0.001), math.log(0.1))
    s5_B_re = nrm(ks[13], (DEPTH, 2, S5_GROUPS, S5_STATE, S5_GROUP), (2 * S5_GROUP) ** -0.5)
    s5_B_im = nrm(ks[14], (DEPTH, 2, S5_GROUPS, S5_STATE, S5_GROUP), (2 * S5_GROUP) ** -0.5)
    s5_C_re = nrm(ks[15], (DEPTH, 2, S5_GROUPS, S5_GROUP, S5_STATE), (2 * S5_STATE) ** -0.5)
    s5_C_im = nrm(ks[16], (DEPTH, 2, S5_GROUPS, S5_GROUP, S5_STATE), (2 * S5_STATE) ** -0.5)
    s5_D = nrm(ks[17], (DEPTH, S5_WIDTH), 1.0)
    s5_glu_w = nrm(ks[18], (DEPTH, S5_WIDTH, S5_WIDTH), S5_WIDTH ** -0.5)
    s5_glu_b = nrm(ks[19], (DEPTH, S5_WIDTH), 0.02)
    w_out = nrm(ks[20], (DEPTH, MIX_WIDTH, D_MODEL), MIX_WIDTH ** -0.5 * BETA)
    ln1_g = 1.0 + nrm(ks[21], (DEPTH, D_MODEL), 0.02)
    ln1_b = nrm(ks[22], (DEPTH, D_MODEL), 0.02)
    ffn_w_up = nrm(ks[23], (DEPTH, D_MODEL, 2 * D_FF), D_MODEL ** -0.5 * BETA)
    ffn_conv_w = nrm(ks[24], (DEPTH, CONV_WIDTH, D_FF), CONV_WIDTH ** -0.5)
    ffn_conv_b = nrm(ks[25], (DEPTH, D_FF), 0.02)
    ffn_w_down = nrm(ks[26], (DEPTH, D_FF, D_MODEL), D_FF ** -0.5 * BETA)
    ple_w = nrm(ks[27], (DEPTH, PLE_DIM, D_MODEL), PLE_DIM ** -0.5 * BETA)
    ple_gate_w = nrm(ks[28], (DEPTH, D_MODEL, D_MODEL), D_MODEL ** -0.5)
    ln2_g = 1.0 + nrm(ks[29], (DEPTH, D_MODEL), 0.02)
    ln2_b = nrm(ks[30], (DEPTH, D_MODEL), 0.02)
    return {'x': x, 'p': p, 'positions': positions, 'w_in': w_in,
            'da_lambda_q1': da_lambda_q1, 'da_lambda_k1': da_lambda_k1,
            'da_lambda_q2': da_lambda_q2, 'da_lambda_k2': da_lambda_k2,
            'da_subln_g': da_subln_g, 'ret_gn_g': ret_gn_g, 'ret_gn_b': ret_gn_b,
            's5_A_re': s5_A_re, 's5_A_im': s5_A_im, 's5_log_dt': s5_log_dt,
            's5_B_re': s5_B_re, 's5_B_im': s5_B_im, 's5_C_re': s5_C_re, 's5_C_im': s5_C_im,
            's5_D': s5_D, 's5_glu_w': s5_glu_w, 's5_glu_b': s5_glu_b,
            'w_out': w_out, 'ln1_g': ln1_g, 'ln1_b': ln1_b,
            'ffn_w_up': ffn_w_up, 'ffn_conv_w': ffn_conv_w, 'ffn_conv_b': ffn_conv_b,
            'ffn_w_down': ffn_w_down, 'ple_w': ple_w, 'ple_gate_w': ple_gate_w,
            'ln2_g': ln2_g, 'ln2_b': ln2_b}


def reference(x, p, positions, w_in, da_lambda_q1, da_lambda_k1, da_lambda_q2, da_lambda_k2,
              da_subln_g, ret_gn_g, ret_gn_b, s5_A_re, s5_A_im, s5_log_dt, s5_B_re, s5_B_im,
              s5_C_re, s5_C_im, s5_D, s5_glu_w, s5_glu_b, w_out, ln1_g, ln1_b,
              ffn_w_up, ffn_conv_w, ffn_conv_b, ffn_w_down, ple_w, ple_gate_w, ln2_g, ln2_b):
    Bsz, L, _ = x.shape
    cos, sin = rope_tables(positions, DA_QK_DIM)
    log_gamma = jnp.log(1.0 - 2.0 ** (-5.0 - jnp.arange(RET_HEADS, dtype=F32)))
    for i in range(DEPTH):
        lambda_init = 0.8 - 0.6 * math.exp(-0.3 * i)
        z = x @ w_in[i]
        dq = z[..., COL_DA_Q:COL_DA_K].reshape(Bsz, L, DA_HEADS, 2, DA_QK_DIM)
        dk = z[..., COL_DA_K:COL_DA_V].reshape(Bsz, L, DA_HEADS, 2, DA_QK_DIM)
        dv = z[..., COL_DA_V:COL_RET_Q].reshape(Bsz, L, DA_HEADS, DA_V_DIM)
        lam = (jnp.exp(jnp.sum(da_lambda_q1[i].astype(F32) * da_lambda_k1[i].astype(F32)))
               - jnp.exp(jnp.sum(da_lambda_q2[i].astype(F32) * da_lambda_k2[i].astype(F32)))
               + lambda_init)
        y_da = diff_attention(dq, dk, dv, cos, sin, lam, da_subln_g[i], lambda_init)
        rq = z[..., COL_RET_Q:COL_RET_K].reshape(Bsz, L, RET_HEADS, RET_HEAD_DIM)
        rk = z[..., COL_RET_K:COL_RET_V].reshape(Bsz, L, RET_HEADS, RET_HEAD_DIM)
        rv = z[..., COL_RET_V:COL_RET_G].reshape(Bsz, L, RET_HEADS, RET_HEAD_DIM)
        rg = z[..., COL_RET_G:COL_S5_U]
        y_ret = retention_block(rq, rk, rv, rg, cos, sin, log_gamma, ret_gn_g[i], ret_gn_b[i])
        u = z[..., COL_S5_U:IN_COLS]
        y_s5 = s5_block(u, s5_A_re[i], s5_A_im[i], s5_log_dt[i], s5_B_re[i], s5_B_im[i],
                        s5_C_re[i], s5_C_im[i], s5_D[i], s5_glu_w[i], s5_glu_b[i])
        mix = jnp.concatenate([y_da, y_ret, y_s5], axis=-1) @ w_out[i]
        x = layer_norm(ALPHA * x + mix, ln1_g[i], ln1_b[i])
        f = conv_ffn(x, ffn_w_up[i], ffn_conv_w[i], ffn_conv_b[i], ffn_w_down[i])
        ple = (p[i] @ ple_w[i]) * jax.nn.sigmoid(x @ ple_gate_w[i])
        x = layer_norm(ALPHA * x + f + ple, ln2_g[i], ln2_b[i])
    return x
```

```cpp
#include <hip/hip_runtime.h>
#include <hip/hip_cooperative_groups.h>
#include <cstdio>
#include <cstdint>
namespace cg = cooperative_groups;

typedef unsigned short u16;
using bf16x8 = __attribute__((ext_vector_type(8))) short;
using s16x4  = __attribute__((ext_vector_type(4))) short;
using f32x16 = __attribute__((ext_vector_type(16))) float;
using u32x4  = __attribute__((ext_vector_type(4))) unsigned;
using u32x2  = __attribute__((ext_vector_type(2))) unsigned;

#ifndef PROBE_MASK
#define PROBE_MASK 0
#endif
#ifndef PROBE_SYNCS
#define PROBE_SYNCS 0
#endif
#ifndef MK_LAUNCHES
#define MK_LAUNCHES 1
#endif

constexpr int TT = 32768, SEQ = 8192, DM = 1024, ZC = 2816, DFF = 2816;
constexpr int C_DAK = 512, C_DAV = 1024, C_RQ = 1536, C_RK = 1792, C_RV = 2048, C_RG = 2304, C_U = 2560;
constexpr float ALPHA = 1.4142135623730951f;
constexpr int NTHR = 256;
constexpr int LDS_BYTES = 74752, LDS_TOTAL = LDS_BYTES + 16;

constexpr size_t al256(size_t x) { return (x + 255) / 256 * 256; }
constexpr size_t SZ_WIN = (size_t)2816 * 1024 * 2, SZ_WOUT = (size_t)1024 * 1024 * 2, SZ_WUP = (size_t)5632 * 1024 * 2,
                 SZ_WDN = (size_t)1024 * 2816 * 2, SZ_WPLE = (size_t)1024 * 256 * 2, SZ_WGATE = (size_t)1024 * 1024 * 2,
                 SZ_WGLU = (size_t)256 * 256 * 2;
constexpr size_t SZ_S5M = (size_t)16 * 512 * 768 * 2, SZ_S5F = (size_t)16 * 256 * 512 * 2;
constexpr size_t OFF_WIN = 0;
constexpr size_t OFF_WOUT = OFF_WIN + 2 * SZ_WIN;
constexpr size_t OFF_WUP = OFF_WOUT + 2 * SZ_WOUT;
constexpr size_t OFF_WDN = OFF_WUP + 2 * SZ_WUP;
constexpr size_t OFF_WPLE = OFF_WDN + 2 * SZ_WDN;
constexpr size_t OFF_WGATE = OFF_WPLE + 2 * SZ_WPLE;
constexpr size_t OFF_WGLU = OFF_WGATE + 2 * SZ_WGATE;
constexpr size_t OFF_S5M = OFF_WGLU + 2 * SZ_WGLU;
constexpr size_t OFF_S5F = OFF_S5M + 2 * SZ_S5M;
constexpr size_t OFF_PW = OFF_S5F + 2 * SZ_S5F;
constexpr size_t SZ_PW = (size_t)2 * 2 * 16 * 64 * 33 * 2 * 4;
constexpr size_t OFF_BB = al256(OFF_PW + SZ_PW);
constexpr size_t SZ_BB = (size_t)2 * 2 * 16 * 64 * 16 * 2 * 4;
constexpr size_t OFF_KTAB = al256(OFF_BB + SZ_BB);
constexpr size_t SZ_KTAB = (size_t)2 * 16 * 2 * 32 * 256 * 4;
constexpr size_t OFF_LAM = al256(OFF_KTAB + SZ_KTAB);
constexpr size_t OFF_BAR = OFF_LAM + 256;
constexpr size_t SZ_BAR = 3456 * 4;
constexpr size_t OFF_ZERO = OFF_BAR + SZ_BAR;
constexpr size_t OFF_KMX = OFF_ZERO + 2048;
constexpr size_t OFF_COS = OFF_KMX + 16384;
constexpr size_t OFF_SIN = OFF_COS + (size_t)TT * 32 * 4;
constexpr size_t OFF_XB = OFF_SIN + (size_t)TT * 32 * 4;
constexpr size_t OFF_R1 = OFF_XB + (size_t)TT * 1024 * 2;
constexpr size_t OFF_Z = OFF_R1;
constexpr size_t OFF_YMIX = OFF_Z + (size_t)TT * ZC * 2;
constexpr size_t OFF_YGB = OFF_YMIX + (size_t)TT * 1024 * 2;
constexpr size_t OFF_XEND = OFF_YGB + (size_t)TT * 256 * 2;
constexpr size_t OFF_SINS = OFF_XEND + (size_t)1024 * 16 * 256 * 4;
constexpr size_t OFF_KVT = OFF_SINS + (size_t)1024 * 16 * 256 * 2;
constexpr size_t OFF_KVS = OFF_KVT + (size_t)16 * 64 * 2 * 4096 * 4;
constexpr size_t OFF_R1END = OFF_KVS + (size_t)16 * 64 * 2 * 4096 * 2;
constexpr size_t OFF_PB = OFF_YGB;
constexpr size_t OFF_HALO = OFF_YMIX;
constexpr size_t OFF_PRE1 = OFF_Z;
constexpr size_t OFF_PRE2 = OFF_YMIX;
constexpr size_t OFF_A = OFF_R1;
constexpr size_t WS_NEED = OFF_R1END;

struct P {
  const float *x, *p; const int* pos;
  const float *w_in, *lq1, *lk1, *lq2, *lk2, *subln, *gn_g, *gn_b, *A_re, *A_im, *log_dt, *B_re, *B_im, *C_re, *C_im, *Dp,
      *glu_w, *glu_b, *w_out, *ln1g, *ln1b, *w_up, *conv_w, *conv_b, *w_down, *ple_w, *gate_w, *ln2g, *ln2b;
  float* out; char* ws;
};

__device__ __forceinline__ unsigned cvtpk(float lo, float hi) {
  unsigned r; asm volatile("v_cvt_pk_bf16_f32 %0, %1, %2" : "=v"(r) : "v"(lo), "v"(hi)); return r;
}
__device__ __forceinline__ u16 f2bf(float x) { return (u16)(cvtpk(x, 0.f) & 0xffffu); }
__device__ __forceinline__ float bf2f(u16 v) { return __uint_as_float(((unsigned)v) << 16); }
__device__ __forceinline__ float4 ntld4(const void* q) {
  typedef float f4_ __attribute__((ext_vector_type(4)));
  const f4_ t = __builtin_nontemporal_load((const f4_*)q); return float4{t[0], t[1], t[2], t[3]};
}
__device__ __forceinline__ int crow(int r, int hi) { return (r & 3) + 8 * (r >> 2) + 4 * hi; }
__device__ __forceinline__ float gelu_t(float x) {
  constexpr float c1 = -2.f * 1.4426950408889634f * 0.7978845608028654f, c2 = c1 * 0.044715f;
  const float t = x * fmaf(c2, x * x, c1);
  return x * __builtin_amdgcn_rcpf(1.f + __builtin_amdgcn_exp2f(t));
}
__device__ __forceinline__ float sigmoidf_(float x) { return __builtin_amdgcn_rcpf(1.f + __expf(-x)); }
__device__ __forceinline__ float half_sum32(float v) {
  v += __shfl_xor(v, 16); v += __shfl_xor(v, 8); v += __shfl_xor(v, 4); v += __shfl_xor(v, 2); v += __shfl_xor(v, 1); return v;
}
__device__ __forceinline__ float wave_sum(float v) { v += __shfl_xor(v, 32); return half_sum32(v); }
__device__ __forceinline__ int ltid() { int t = (int)threadIdx.x; asm volatile("" : "+v"(t)); return t; }
__device__ __forceinline__ int opq() { int z = 0; asm volatile("" : "+v"(z)); return z; }
#define SBAR() __builtin_amdgcn_sched_barrier(0)
#define MFMA(a, b, c) __builtin_amdgcn_mfma_f32_32x32x16_bf16(a, b, c, 0, 0, 0)

struct LdBf { const u16* base; long ld;
  __device__ __forceinline__ const u16* ptr(int row, int k) const { return base + (long)row * ld + k; } };
struct LdS5 { const u16* z; const u16* sins; int g; int chunk0;
  __device__ __forceinline__ const u16* ptr(int row, int k) const {
    const long chunk = chunk0 + row;
    return (k < 512) ? z + (chunk * 32 + (k >> 4)) * ZC + C_U + g * 16 + (k & 15) : sins + (chunk * 16 + g) * 256 + (k - 512); } };
struct LdBsplit { const u16* base; long ld; int f0;
  __device__ __forceinline__ const u16* ptr(int row, int k) const {
    const int rr = (row < 64) ? f0 + row : DFF + f0 + row - 64; return base + (long)rr * ld + k; } };
__device__ __forceinline__ void glds16(const void* g, void* l) {
  __builtin_amdgcn_global_load_lds((const __attribute__((address_space(1))) unsigned*)g, (__attribute__((address_space(3))) unsigned*)l, 16, 0, 0);
}

template <bool HALO, class AL, class BL>
__device__ __forceinline__ void gemm_core(f32x16 (&acc)[2][2], f32x16& hacc, const AL& al, const BL& bl, int K, char* lds,
                                          const u16* halo0, const u16* halo1, int brow0, int brow1) {
  constexpr int ABYTES = HALO ? 136 * 128 : 128 * 128, BUF = ABYTES + 16384;
  const int tid = ltid(), lane = tid & 63, wid = tid >> 6, wr = wid >> 1, r32 = lane & 31, hi = lane >> 5;
  const int lrow = tid >> 3, cg = ((tid & 7) ^ ((lrow >> 1) & 7)) * 8;
  const u16* gh = nullptr;
  if (HALO) { const int c = ((lane & 7) ^ ((lane >> 4) & 7)) * 8; gh = ((lane < 8) ? halo0 : halo1) + c; }
  char* lw = lds + tid * 16;
#define ISSUE(k0, bf) do { char* A_ = lw + (bf) * BUF; \
    _Pragma("unroll") for (int i_ = 0; i_ < 4; ++i_) { glds16(al.ptr(lrow + 32 * i_, (k0) + cg), A_ + i_ * 4096); glds16(bl.ptr(lrow + 32 * i_, (k0) + cg), A_ + ABYTES + i_ * 4096); } \
    if (HALO) { if (wid == 0) glds16(gh + (k0), A_ + 16384); } } while (0)
  const int sa = ((wr * 64 + r32) >> 1) & 7, sb0 = ((brow0 + r32) >> 1) & 7, sb1 = ((brow1 + r32) >> 1) & 7, sh = (r32 >> 1) & 7;
  const int oa = (wr * 64 + r32) * 128, ob0 = ABYTES + (brow0 + r32) * 128, ob1 = ABYTES + (brow1 + r32) * 128, oh = (128 + r32) * 128;
  __syncthreads();
  ISSUE(0, 0);
  const int nk = K >> 6;
  for (int kt = 0; kt < nk; ++kt) {
    asm volatile("s_waitcnt vmcnt(0)" ::: "memory");
    __syncthreads();
    if (kt + 1 < nk) ISSUE((kt + 1) * 64, (kt + 1) & 1);
    const char* T = lds + (kt & 1) * BUF;
#pragma unroll
    for (int kk = 0; kk < 4; ++kk) {
      const int c = kk * 2 + hi;
      bf16x8 a0 = *(const bf16x8*)(T + oa + ((c ^ sa) << 4));
      bf16x8 a1 = *(const bf16x8*)(T + oa + 4096 + ((c ^ sa) << 4));
      bf16x8 b0 = *(const bf16x8*)(T + ob0 + ((c ^ sb0) << 4));
      bf16x8 b1 = *(const bf16x8*)(T + ob1 + ((c ^ sb1) << 4));
      acc[0][0] = MFMA(a0, b0, acc[0][0]); acc[0][1] = MFMA(a0, b1, acc[0][1]);
      acc[1][0] = MFMA(a1, b0, acc[1][0]); acc[1][1] = MFMA(a1, b1, acc[1][1]);
      if (HALO) { bf16x8 ah = *(const bf16x8*)(T + oh + ((c ^ sh) << 4)); hacc = MFMA(ah, b0, hacc); }
    }
  }
#undef ISSUE
}
template <class AL, class BL>
__device__ __forceinline__ void gemm_plain(f32x16 (&acc)[2][2], const AL& al, const BL& bl, int K, char* lds) {
  f32x16 dummy = {};
  const int wc = (ltid() >> 6) & 1;
  gemm_core<false>(acc, dummy, al, bl, K, lds, nullptr, nullptr, wc * 64, wc * 64 + 32);
}
__device__ __forceinline__ bool tile_at(int it, int nM, int nN, int& tm, int& tn) {
  const int total = nM * nN, per = (total + 7) / 8, x = blockIdx.x & 7, lb = blockIdx.x >> 3, nlb = gridDim.x >> 3;
  const int i = lb + it * nlb; if (i >= per) return false;
  const int idx = x * per + i; if (idx >= total) return false;
  const int grp = idx / (8 * nN), rem = idx - grp * 8 * nN;
  tm = grp * 8 + (rem & 7); tn = rem >> 3; return true;
}

__device__ __forceinline__ void transpose_tile(const float* src, u16* dst, int K, int N, int kt, int nt, char* lds) {
  float* tile = (float*)lds;
  const int tid = ltid();
  __syncthreads();
#pragma unroll
  for (int i = 0; i < 4; ++i) {
    const int e = tid + 256 * i, r = e >> 4, c4 = (e & 15) * 4;
    const float4 v = ntld4(src + (long)(kt * 64 + r) * N + nt * 64 + c4);
    tile[r * 65 + c4] = v.x; tile[r * 65 + c4 + 1] = v.y; tile[r * 65 + c4 + 2] = v.z; tile[r * 65 + c4 + 3] = v.w;
  }
  __syncthreads();
#pragma unroll
  for (int i = 0; i < 2; ++i) {
    const int e = tid + 256 * i, n = e >> 3, k8 = (e & 7) * 8;
    u32x4 w;
    w.x = cvtpk(tile[(k8 + 0) * 65 + n], tile[(k8 + 1) * 65 + n]); w.y = cvtpk(tile[(k8 + 2) * 65 + n], tile[(k8 + 3) * 65 + n]);
    w.z = cvtpk(tile[(k8 + 4) * 65 + n], tile[(k8 + 5) * 65 + n]); w.w = cvtpk(tile[(k8 + 6) * 65 + n], tile[(k8 + 7) * 65 + n]);
    *(u32x4*)(dst + (long)(nt * 64 + n) * K + kt * 64 + k8) = w;
  }
}
__device__ __forceinline__ void phase0(const P& p, char* lds) {
  const int tid = ltid(), bid = blockIdx.x, nb = gridDim.x;
  for (int layer = 0; layer < 2; ++layer) {
    for (int m = 0; m < 7; ++m) {
      const float* src; u16* dst; int K, N;
      switch (m) {
        case 0: src = p.w_in + (size_t)layer * 1024 * 2816; dst = (u16*)(p.ws + OFF_WIN + layer * SZ_WIN); K = 1024; N = 2816; break;
        case 1: src = p.w_out + (size_t)layer * 1024 * 1024; dst = (u16*)(p.ws + OFF_WOUT + layer * SZ_WOUT); K = 1024; N = 1024; break;
        case 2: src = p.w_up + (size_t)layer * 1024 * 5632; dst = (u16*)(p.ws + OFF_WUP + layer * SZ_WUP); K = 1024; N = 5632; break;
        case 3: src = p.w_down + (size_t)layer * 2816 * 1024; dst = (u16*)(p.ws + OFF_WDN + layer * SZ_WDN); K = 2816; N = 1024; break;
        case 4: src = p.ple_w + (size_t)layer * 256 * 1024; dst = (u16*)(p.ws + OFF_WPLE + layer * SZ_WPLE); K = 256; N = 1024; break;
        case 5: src = p.gate_w + (size_t)layer * 1024 * 1024; dst = (u16*)(p.ws + OFF_WGATE + layer * SZ_WGATE); K = 1024; N = 1024; break;
        default: src = p.glu_w + (size_t)layer * 256 * 256; dst = (u16*)(p.ws + OFF_WGLU + layer * SZ_WGLU); K = 256; N = 256; break;
      }
      const int nkt = K / 64, nnt = N / 64;
      for (int t = bid; t < nkt * nnt; t += nb) transpose_tile(src, dst, K, N, t / nnt, t % nnt, lds);
    }
  }
  const long gt = (long)bid * NTHR + tid, gn = (long)nb * NTHR;
  { u16* xb = (u16*)(p.ws + OFF_XB);
    for (long i = gt; i < (long)TT * DM / 8; i += gn) {
      const float4* q = (const float4*)(p.x + i * 8); float4 a = ntld4(q), b = ntld4(q + 1);
      u32x4 w = {cvtpk(a.x, a.y), cvtpk(a.z, a.w), cvtpk(b.x, b.y), cvtpk(b.z, b.w)};
      *(u32x4*)(xb + i * 8) = w; } }
  { float* ct = (float*)(p.ws + OFF_COS); float* st = (float*)(p.ws + OFF_SIN);
    for (long i = gt; i < (long)TT * 32; i += gn) {
      const int t = (int)(i >> 5), j = (int)(i & 31);
      const float inv = powf(10000.f, -(float)(2 * j) / 64.f);
      const float ang = (float)p.pos[t] * inv;
      float s, c; sincosf(ang, &s, &c); ct[i] = c; st[i] = s; } }
  { float* pw = (float*)(p.ws + OFF_PW); float* bb = (float*)(p.ws + OFF_BB);
    for (long t = gt; t < (long)4096 * 33; t += gn) {
      const long i = t / 33; const int k = (int)(t - i * 33);
      const double are = p.A_re[i], aim = p.A_im[i], step = exp((double)p.log_dt[i >> 6]);
      const double mag = exp(k * step * are), ang = k * step * aim;
      pw[t * 2] = (float)(mag * cos(ang)); pw[t * 2 + 1] = (float)(mag * sin(ang));
    }
    for (long t = gt; t < (long)4096 * 16; t += gn) {
      const long i = t >> 4;
      const double are = p.A_re[i], aim = p.A_im[i], step = exp((double)p.log_dt[i >> 6]);
      const double e = exp(step * are), abr = e * cos(step * aim), abi = e * sin(step * aim);
      const double den = are * are + aim * aim, nr = abr - 1.0, ni = abi;
      const double cre = (nr * are + ni * aim) / den, cim = (ni * are - nr * aim) / den;
      const double br = p.B_re[t], bi = p.B_im[t];
      bb[t * 2] = (float)(cre * br - cim * bi); bb[t * 2 + 1] = (float)(cre * bi + cim * br);
    } }
  if (gt < 512) ((unsigned*)(p.ws + OFF_ZERO))[gt] = 0u;
  if (gt < 2) {
    const int l = (int)gt; float s1 = 0.f, s2 = 0.f;
    for (int j = 0; j < 64; ++j) { s1 += p.lq1[l * 64 + j] * p.lk1[l * 64 + j]; s2 += p.lq2[l * 64 + j] * p.lk2[l * 64 + j]; }
    const float linit = 0.8f - 0.6f * expf(-0.3f * (float)l);
    ((float*)(p.ws + OFF_LAM))[l] = expf(s1) - expf(s2) + linit;
    ((float*)(p.ws + OFF_LAM))[2 + l] = 1.f - linit;
  }
}

__device__ __forceinline__ void s5_build_ktab_F(const P& p) {
  const unsigned gt = blockIdx.x * NTHR + ltid(), gn = gridDim.x * NTHR;
  const float* pw = (const float*)(p.ws + OFF_PW); const float* bb = (const float*)(p.ws + OFF_BB);
  float* kt = (float*)(p.ws + OFF_KTAB);
  for (unsigned i = gt; i < 2u * 16 * 2 * 32 * 256; i += gn) {
    const int ci = (int)(i & 15), co = (int)((i >> 4) & 15), lag = (int)((i >> 8) & 31), dir = (int)((i >> 13) & 1), g = (int)((i >> 14) & 15), l = (int)(i >> 18);
    const long ldg = ((long)(l * 2 + dir) * 16 + g);
    const float* cre = p.C_re + (ldg * 16 + co) * 64; const float* cim = p.C_im + (ldg * 16 + co) * 64;
    float s = 0.f;
    for (int q = 0; q < 64; ++q) {
      const long lp = ldg * 64 + q;
      const float pr = pw[(lp * 33 + lag) * 2], pi = pw[(lp * 33 + lag) * 2 + 1];
      const float br = bb[(lp * 16 + ci) * 2], bi = bb[(lp * 16 + ci) * 2 + 1];
      const float wre = pr * br - pi * bi, wim = pr * bi + pi * br;
      s += cre[q] * wre - cim[q] * wim;
    }
    kt[i] = s;
  }
  for (unsigned i = gt; i < 2u * 16 * 256 * 512; i += gn) {
    const int kk = (int)(i & 511), n = (int)((i >> 9) & 255), g = (int)((i >> 17) & 15), l = (int)(i >> 21);
    const int dir = n >> 7, isim = (n >> 6) & 1, q = n & 63, j = kk >> 4, ci = kk & 15;
    const long lp = (((long)(l * 2 + dir) * 16 + g) * 64 + q);
    const int pwk = dir ? j : 31 - j;
    const float pr = pw[(lp * 33 + pwk) * 2], pi = pw[(lp * 33 + pwk) * 2 + 1];
    const float br = bb[(lp * 16 + ci) * 2], bi = bb[(lp * 16 + ci) * 2 + 1];
    const float v = isim ? (pr * bi + pi * br) : (pr * br - pi * bi);
    ((u16*)(p.ws + OFF_S5F))[i] = f2bf(v);
  }
}
__device__ __forceinline__ void s5_build_M(const P& p) {
  const unsigned gt = blockIdx.x * NTHR + ltid(), gn = gridDim.x * NTHR;
  const float* pw = (const float*)(p.ws + OFF_PW); const float* kt = (const float*)(p.ws + OFF_KTAB);
  for (unsigned i = gt; i < 2u * 16 * 512 * 768; i += gn) {
    const unsigned r = i / 768u; const int kk = (int)(i - r * 768u); const int n = (int)(r & 511), g = (int)((r >> 9) & 15), l = (int)(r >> 13);
    const int ii = n >> 4, co = n & 15;
    float v;
    if (kk < 512) {
      const int j = kk >> 4, ci = kk & 15;
      const float* k0 = kt + ((long)(l * 16 + g) * 2 + 0) * 32 * 256; const float* k1 = k0 + 32 * 256;
      if (ii > j) v = k0[(ii - j) * 256 + co * 16 + ci];
      else if (ii < j) v = k1[(j - ii) * 256 + co * 16 + ci];
      else v = k0[co * 16 + ci] + k1[co * 16 + ci] + (co == ci ? p.Dp[l * 256 + g * 16 + co] : 0.f);
    } else {
      const int qq = kk - 512, dir = qq >> 7, isim = (qq >> 6) & 1, q = qq & 63;
      const long ldg = ((long)(l * 2 + dir) * 16 + g);
      const int pwk = dir ? 32 - ii : ii + 1;
      const float pr = pw[((ldg * 64 + q) * 33 + pwk) * 2], pi = pw[((ldg * 64 + q) * 33 + pwk) * 2 + 1];
      const float cr = p.C_re[(ldg * 16 + co) * 64 + q], cim = p.C_im[(ldg * 16 + co) * 64 + q];
      v = isim ? -(cr * pi + cim * pr) : (cr * pr - cim * pi);
    }
    ((u16*)(p.ws + OFF_S5M))[i] = f2bf(v);
  }
}

__device__ __forceinline__ void phase_z(const P& p, int layer, char* lds) {
  const u16* xb = (const u16*)(p.ws + OFF_XB); const u16* wt = (const u16*)(p.ws + OFF_WIN + layer * SZ_WIN);
  u16* z = (u16*)(p.ws + OFF_Z);
  const float* ct = (const float*)(p.ws + OFF_COS); const float* st = (const float*)(p.ws + OFF_SIN);
  const int lane = ltid() & 63, wid = ltid() >> 6, wr = wid >> 1, wc = wid & 1, r32 = lane & 31, hi = lane >> 5;
  int tm, tn;
  for (int it = 0; tile_at(it, 256, 22, tm, tn); ++it) {
    f32x16 acc[2][2] = {};
    LdBf al{xb + (long)tm * 128 * DM, DM}, bl{wt + (long)tn * 128 * DM, DM};
    gemm_plain(acc, al, bl, DM, lds);
    const int span = tn * 2 + wc, colb = span * 64;
    const bool rope = (span < 16) || (span >= 24 && span < 32);
    const float sc = (span < 8 || (span >= 28 && span < 32)) ? 0.125f : 1.f;
    const unsigned rb = (unsigned)(tm * 128 + wr * 64 + 4 * hi + opq());
    if (rope) {
#pragma unroll
      for (int mi = 0; mi < 2; ++mi) {
        float cc[16], ss[16];
#pragma unroll
        for (int r = 0; r < 16; ++r) { const unsigned row = rb + mi * 32 + (r & 3) + 8 * (r >> 2); cc[r] = ct[row * 32 + r32]; ss[r] = st[row * 32 + r32]; }
#pragma unroll
        for (int r = 0; r < 16; ++r) {
          const unsigned row = rb + mi * 32 + (r & 3) + 8 * (r >> 2);
          const float x1 = acc[mi][0][r], x2 = acc[mi][1][r];
          const unsigned w = cvtpk((x1 * cc[r] - x2 * ss[r]) * sc, (x2 * cc[r] + x1 * ss[r]) * sc);
          z[row * ZC + colb + r32] = (u16)w; z[row * ZC + colb + 32 + r32] = (u16)(w >> 16);
        }
        SBAR();
      }
    } else {
#pragma unroll
      for (int mi = 0; mi < 2; ++mi) {
#pragma unroll
        for (int r = 0; r < 16; ++r) {
          const unsigned row = rb + mi * 32 + (r & 3) + 8 * (r >> 2);
          const unsigned w = cvtpk(acc[mi][0][r] * sc, acc[mi][1][r] * sc);
          z[row * ZC + colb + r32] = (u16)w; z[row * ZC + colb + 32 + r32] = (u16)(w >> 16);
        }
        SBAR();
      }
    }
  }
}

__device__ __forceinline__ float ret_log2gamma(int h) { return log2f(1.f - exp2f(-5.f - (float)h)); }
__device__ __forceinline__ void ret_kv_item(const P& p, int item, char* lds) {
  const int tid = ltid(), lane = tid & 63, wid = tid >> 6, r32 = lane & 31, hi = lane >> 5;
  const int c = item & 63, h = (item >> 6) & 3, b = item >> 8;
  const u16* z = (const u16*)(p.ws + OFF_Z);
  const long tok0 = (long)b * SEQ + c * 128;
  u16* VT = (u16*)lds; u16* KF = VT + 64 * 136; u16* KB = KF + 64 * 136;
  const float lg = ret_log2gamma(h);
  { const int j = tid & 127, m = tid >> 7;
    const u16* kp = z + (tok0 + j) * ZC + C_DAK + h * 128 + m * 64;
    float ss = 0.f;
#pragma unroll
    for (int q8 = 0; q8 < 8; ++q8) { const bf16x8 kv = *(const bf16x8*)(kp + q8 * 8);
#pragma unroll
      for (int q = 0; q < 8; ++q) { const float f = bf2f((u16)kv[q]); ss += f * f; } }
#pragma unroll
    for (int o = 32; o >= 1; o >>= 1) ss = fmaxf(ss, __shfl_xor(ss, o));
    if (lane == 0) ((float*)(p.ws + OFF_KMX))[(((b * 4 + h) * 2 + m) * 64 + c) * 2 + (wid & 1)] = ss; }
  __syncthreads();
  for (int e = tid; e < 128 * 8; e += NTHR) {
    const int j = e >> 3, c8 = (e & 7) * 8;
    const bf16x8 kv = *(const bf16x8*)(z + (tok0 + j) * ZC + C_RK + h * 64 + c8);
    const bf16x8 vv = *(const bf16x8*)(z + (tok0 + j) * ZC + C_RV + h * 64 + c8);
    const float df = exp2f(lg * (float)(127 - j)), db = exp2f(lg * (float)j);
#pragma unroll
    for (int q = 0; q < 8; ++q) {
      const float kf = bf2f((u16)kv[q]);
      KF[(c8 + q) * 136 + j] = f2bf(kf * df); KB[(c8 + q) * 136 + j] = f2bf(kf * db); VT[(c8 + q) * 136 + j] = (u16)vv[q];
    }
  }
  __syncthreads();
  const int dir = wid >> 1, vb = wid & 1;
  const u16* KT = dir ? KB : KF;
  f32x16 a0 = {}, a1 = {};
#pragma unroll
  for (int ks = 0; ks < 8; ++ks) {
    const int ko = ks * 16 + hi * 8;
    const bf16x8 av = *(const bf16x8*)&VT[(vb * 32 + r32) * 136 + ko];
    const bf16x8 b0 = *(const bf16x8*)&KT[(r32) * 136 + ko];
    const bf16x8 b1 = *(const bf16x8*)&KT[(32 + r32) * 136 + ko];
    a0 = MFMA(av, b0, a0); a1 = MFMA(av, b1, a1);
  }
  float* kvt = (float*)(p.ws + OFF_KVT) + ((long)((b * 4 + h) * 64 + c) * 2 + dir) * 4096;
#pragma unroll
  for (int r = 0; r < 16; ++r) { const int v = vb * 32 + crow(r, hi); kvt[v * 64 + r32] = a0[r]; kvt[v * 64 + 32 + r32] = a1[r]; }
}
__device__ __forceinline__ void ret_scan(const P& p) {
  const long gt = (long)blockIdx.x * NTHR + ltid(), gn = (long)gridDim.x * NTHR;
  const float* kvt = (const float*)(p.ws + OFF_KVT); u16* kvs = (u16*)(p.ws + OFF_KVS);
  for (long i = gt; i < 16 * 2 * 4096; i += gn) {
    const int e = (int)(i & 4095), dir = (int)((i >> 12) & 1), bh = (int)(i >> 13), h = bh & 3;
    const float cd = exp2f(ret_log2gamma(h) * 128.f);
    float s = 0.f;
    const long base = ((long)(bh * 64) * 2 + dir) * 4096 + e;
    float v[64];
#pragma unroll
    for (int cc = 0; cc < 64; ++cc) v[cc] = kvt[base + (long)(dir ? 63 - cc : cc) * 8192];
#pragma unroll
    for (int cc = 0; cc < 64; ++cc) { kvs[base + (long)(dir ? 63 - cc : cc) * 8192] = f2bf(s); s = cd * s + v[cc]; }
  }
}
__device__ __forceinline__ void ret_out_item(const P& p, int layer, int item, char* lds) {
  const int tid = ltid(), lane = tid & 63, wid = tid >> 6, r32 = lane & 31, hi = lane >> 5;
  const int c = item & 63, h = (item >> 6) & 3, b = item >> 8;
  const u16* z = (const u16*)(p.ws + OFF_Z);
  const long tok0 = (long)b * SEQ + c * 128;
  u16* Qs = (u16*)lds; u16* Ks = Qs + 128 * 72; u16* VT = Ks + 128 * 72; u16* SF = VT + 64 * 136; u16* SB = SF + 64 * 72;
  const float lg = ret_log2gamma(h);
  __syncthreads();
  for (int e = tid; e < 128 * 8; e += NTHR) {
    const int j = e >> 3, c8 = (e & 7) * 8;
    *(bf16x8*)&Qs[j * 72 + c8] = *(const bf16x8*)(z + (tok0 + j) * ZC + C_RQ + h * 64 + c8);
    *(bf16x8*)&Ks[j * 72 + c8] = *(const bf16x8*)(z + (tok0 + j) * ZC + C_RK + h * 64 + c8);
    const bf16x8 vv = *(const bf16x8*)(z + (tok0 + j) * ZC + C_RV + h * 64 + c8);
#pragma unroll
    for (int q = 0; q < 8; ++q) VT[(c8 + q) * 136 + j] = (u16)vv[q];
  }
  { const u16* kvs = (const u16*)(p.ws + OFF_KVS) + ((long)((b * 4 + h) * 64 + c) * 2) * 4096;
    for (int e = tid; e < 2 * 64 * 8; e += NTHR) {
      const int dir = e >> 9, v = (e >> 3) & 63, c8 = (e & 7) * 8;
      *(bf16x8*)&((dir ? SB : SF)[v * 72 + c8]) = *(const bf16x8*)(kvs + (long)dir * 4096 + v * 64 + c8);
    } }
  __syncthreads();
  const int il = wid * 32 + r32;
  bf16x8 qf[4];
#pragma unroll
  for (int d0 = 0; d0 < 4; ++d0) qf[d0] = *(const bf16x8*)&Qs[il * 72 + d0 * 16 + hi * 8];
  bf16x8 pa[8];
#pragma unroll
  for (int jb = 0; jb < 4; ++jb) {
    f32x16 s = {};
#pragma unroll
    for (int d0 = 0; d0 < 4; ++d0) { const bf16x8 kf = *(const bf16x8*)&Ks[(jb * 32 + r32) * 72 + d0 * 16 + hi * 8]; s = MFMA(kf, qf[d0], s); }
#pragma unroll
    for (int r = 0; r < 16; ++r) { const int j = jb * 32 + crow(r, hi); const int dd = il > j ? il - j : j - il; s[r] *= exp2f(lg * (float)dd); }
#define PK4(PV, BASE, OUT) do { unsigned a0_ = cvtpk(PV[BASE + 0], PV[BASE + 1]), a1_ = cvtpk(PV[BASE + 2], PV[BASE + 3]);   \
    unsigned b0_ = cvtpk(PV[BASE + 4], PV[BASE + 5]), b1_ = cvtpk(PV[BASE + 6], PV[BASE + 7]);                              \
    auto r0_ = __builtin_amdgcn_permlane32_swap(a0_, b0_, false, false); auto r1_ = __builtin_amdgcn_permlane32_swap(a1_, b1_, false, false); \
    u32x4 w_ = {r0_[0], r1_[0], r0_[1], r1_[1]}; OUT = *reinterpret_cast<bf16x8*>(&w_); } while (0)
    PK4(s, 0, pa[2 * jb]); PK4(s, 8, pa[2 * jb + 1]);
  }
  f32x16 in0 = {}, in1 = {}, cf0 = {}, cf1 = {}, cb0 = {}, cb1 = {};
#pragma unroll
  for (int ks = 0; ks < 8; ++ks) {
    const bf16x8 v0 = *(const bf16x8*)&VT[(r32) * 136 + ks * 16 + hi * 8];
    const bf16x8 v1 = *(const bf16x8*)&VT[(32 + r32) * 136 + ks * 16 + hi * 8];
    in0 = MFMA(pa[ks], v0, in0); in1 = MFMA(pa[ks], v1, in1);
  }
#pragma unroll
  for (int d0 = 0; d0 < 4; ++d0) {
    const int ko = d0 * 16 + hi * 8;
    const bf16x8 f0 = *(const bf16x8*)&SF[(r32) * 72 + ko], f1 = *(const bf16x8*)&SF[(32 + r32) * 72 + ko];
    const bf16x8 g0 = *(const bf16x8*)&SB[(r32) * 72 + ko], g1 = *(const bf16x8*)&SB[(32 + r32) * 72 + ko];
    cf0 = MFMA(qf[d0], f0, cf0); cf1 = MFMA(qf[d0], f1, cf1); cb0 = MFMA(qf[d0], g0, cb0); cb1 = MFMA(qf[d0], g1, cb1);
  }
  const float gg0 = p.gn_g[layer * 64 + r32], gg1 = p.gn_g[layer * 64 + 32 + r32], gb0 = p.gn_b[layer * 64 + r32], gb1 = p.gn_b[layer * 64 + 32 + r32];
  u16* ymix = (u16*)(p.ws + OFF_YMIX);
  const int ib = wid * 32 + 4 * hi + opq();
  u16 gv0[16], gv1[16];
#pragma unroll
  for (int r = 0; r < 16; ++r) { const unsigned row = (unsigned)tok0 + ib + (r & 3) + 8 * (r >> 2);
    gv0[r] = z[row * ZC + C_RG + h * 64 + r32]; gv1[r] = z[row * ZC + C_RG + h * 64 + 32 + r32]; }
#pragma unroll
  for (int r = 0; r < 16; ++r) {
    const int i = ib + (r & 3) + 8 * (r >> 2);
    const float qd_f = exp2f(lg * (float)(i + 1)), qd_b = exp2f(lg * (float)(128 - i));
    const float o0 = in0[r] + qd_f * cf0[r] + qd_b * cb0[r], o1 = in1[r] + qd_f * cf1[r] + qd_b * cb1[r];
    const float mu = half_sum32(o0 + o1) * (1.f / 64.f);
    const float e0 = o0 - mu, e1 = o1 - mu;
    const float var = half_sum32(e0 * e0 + e1 * e1) * (1.f / 64.f);
    const float rs = rsqrtf(var + 1e-5f);
    const unsigned row = (unsigned)tok0 + i;
    const float g0 = bf2f(gv0[r]), g1 = bf2f(gv1[r]);
    ymix[row * 1024 + 512 + h * 64 + r32] = f2bf(g0 * sigmoidf_(g0) * (e0 * rs * gg0 + gb0));
    ymix[row * 1024 + 512 + h * 64 + 32 + r32] = f2bf(g1 * sigmoidf_(g1) * (e1 * rs * gg1 + gb1));
  }
}

__device__ __forceinline__ void s5_state_tile(const P& p, int layer, int t, char* lds) {
  const int g = t >> 4, tm = (t >> 1) & 7, tn = t & 1;
  const int lane = ltid() & 63, wid = ltid() >> 6, wr = wid >> 1, wc = wid & 1, r32 = lane & 31, hi = lane >> 5;
  f32x16 acc[2][2] = {};
  LdS5 al{(const u16*)(p.ws + OFF_Z), nullptr, g, tm * 128};
  LdBf bl{(const u16*)(p.ws + OFF_S5F + layer * SZ_S5F) + ((long)g * 256 + tn * 128) * 512, 512};
  gemm_plain(acc, al, bl, 512, lds);
  float* xe = (float*)(p.ws + OFF_XEND);
  const unsigned cb = (unsigned)(tm * 128 + wr * 64 + 4 * hi + opq());
#pragma unroll
  for (int mi = 0; mi < 2; ++mi) {
#pragma unroll
    for (int ni = 0; ni < 2; ++ni)
#pragma unroll
      for (int r = 0; r < 16; ++r) {
        const unsigned chunk = cb + mi * 32 + (r & 3) + 8 * (r >> 2); const unsigned n = tn * 128 + wc * 64 + ni * 32 + r32;
        xe[(chunk * 16 + g) * 256 + n] = acc[mi][ni][r];
      }
    SBAR();
  }
}
__device__ __forceinline__ void s5_scan(const P& p, int layer) {
  const long gt = (long)blockIdx.x * NTHR + ltid();
  if (gt >= 4 * 16 * 2 * 64) return;
  const int q = (int)(gt & 63), dir = (int)((gt >> 6) & 1), g = (int)((gt >> 7) & 15), b = (int)(gt >> 11);
  const float* pw = (const float*)(p.ws + OFF_PW);
  const long lp = (((long)(layer * 2 + dir) * 16 + g) * 64 + q);
  const float ar = pw[(lp * 33 + 32) * 2], ai = pw[(lp * 33 + 32) * 2 + 1];
  const float* xe = (const float*)(p.ws + OFF_XEND); u16* ss = (u16*)(p.ws + OFF_SINS);
  float sr = 0.f, si = 0.f;
  const long base = ((long)(b * 256) * 16 + g) * 256 + dir * 128 + q;
  for (int c0 = 0; c0 < 256; c0 += 32) {
    float xr[32], xi[32];
#pragma unroll
    for (int k = 0; k < 32; ++k) { const long off = base + (long)(dir ? 255 - (c0 + k) : c0 + k) * 4096; xr[k] = xe[off]; xi[k] = xe[off + 64]; }
#pragma unroll
    for (int k = 0; k < 32; ++k) {
      const long off = base + (long)(dir ? 255 - (c0 + k) : c0 + k) * 4096;
      ss[off] = f2bf(sr); ss[off + 64] = f2bf(si);
      const float nr = ar * sr - ai * si + xr[k], ni = ar * si + ai * sr + xi[k];
      sr = nr; si = ni;
    }
  }
}
__device__ __forceinline__ void s5_out_tile(const P& p, int layer, int t, char* lds) {
  const int g = t >> 5, tm = (t >> 2) & 7, tn = t & 3;
  const int lane = ltid() & 63, wid = ltid() >> 6, wr = wid >> 1, wc = wid & 1, r32 = lane & 31, hi = lane >> 5;
  f32x16 acc[2][2] = {};
  LdS5 al{(const u16*)(p.ws + OFF_Z), (const u16*)(p.ws + OFF_SINS), g, tm * 128};
  LdBf bl{(const u16*)(p.ws + OFF_S5M + layer * SZ_S5M) + ((long)g * 512 + tn * 128) * 768, 768};
  gemm_plain(acc, al, bl, 768, lds);
  u16* yg = (u16*)(p.ws + OFF_YGB);
  const unsigned cb = (unsigned)(tm * 128 + wr * 64 + 4 * hi + opq());
#pragma unroll
  for (int mi = 0; mi < 2; ++mi) {
#pragma unroll
    for (int ni = 0; ni < 2; ++ni)
#pragma unroll
      for (int r = 0; r < 16; ++r) {
        const unsigned chunk = cb + mi * 32 + (r & 3) + 8 * (r >> 2); const unsigned n = tn * 128 + wc * 64 + ni * 32 + r32;
        yg[(chunk * 32 + (n >> 4)) * 256 + g * 16 + (n & 15)] = f2bf(gelu_t(acc[mi][ni][r]));
      }
    SBAR();
  }
}
__device__ __forceinline__ void phase_glu(const P& p, int layer, char* lds) {
  const u16* yg = (const u16*)(p.ws + OFF_YGB); const u16* wt = (const u16*)(p.ws + OFF_WGLU + layer * SZ_WGLU);
  u16* ymix = (u16*)(p.ws + OFF_YMIX);
  const int lane = ltid() & 63, wid = ltid() >> 6, wr = wid >> 1, wc = wid & 1, r32 = lane & 31, hi = lane >> 5;
  int tm, tn;
  for (int it = 0; tile_at(it, 256, 2, tm, tn); ++it) {
    f32x16 acc[2][2] = {};
    LdBf al{yg + (long)tm * 128 * 256, 256}, bl{wt + (long)tn * 128 * 256, 256};
    gemm_plain(acc, al, bl, 256, lds);
    const unsigned rb = (unsigned)(tm * 128 + wr * 64 + 4 * hi + opq());
#pragma unroll
    for (int mi = 0; mi < 2; ++mi) {
#pragma unroll
      for (int ni = 0; ni < 2; ++ni) {
        const unsigned col = tn * 128 + wc * 64 + ni * 32 + r32;
        const float gb = p.glu_b[layer * 256 + col];
        u16 yv[16];
#pragma unroll
        for (int r = 0; r < 16; ++r) yv[r] = yg[(rb + mi * 32 + (r & 3) + 8 * (r >> 2)) * 256 + col];
#pragma unroll
        for (int r = 0; r < 16; ++r) {
          const unsigned row = rb + mi * 32 + (r & 3) + 8 * (r >> 2);
          ymix[row * 1024 + 768 + col] = f2bf(bf2f(yv[r]) * sigmoidf_(acc[mi][ni][r] + gb));
        }
      }
      SBAR();
    }
  }
}

constexpr float ATHR = 8.f;
__device__ __forceinline__ void partialSM(f32x16& p0, f32x16& p1, float& m_reg, float& mn, float& alpha) {
  constexpr float C = 1.4426950408889634f;
  float pmax = p0[0];
#pragma unroll
  for (int r = 1; r < 16; ++r) pmax = fmaxf(pmax, p0[r]);
#pragma unroll
  for (int r = 0; r < 16; ++r) pmax = fmaxf(pmax, p1[r]);
  { auto rr = __builtin_amdgcn_permlane32_swap(__float_as_uint(pmax), __float_as_uint(pmax), false, false);
    pmax = fmaxf(__uint_as_float(rr[0]), __uint_as_float(rr[1])); }
  if (__builtin_expect(__all(pmax - m_reg <= ATHR), 1)) { mn = m_reg; alpha = 1.f; }
  else { mn = fmaxf(m_reg, pmax); alpha = __builtin_amdgcn_exp2f((m_reg - mn) * C); m_reg = mn; }
  const float mnC = -mn * C;
#pragma unroll
  for (int r = 0; r < 16; ++r) p0[r] = __builtin_amdgcn_exp2f(fmaf(p0[r], C, mnC));
#pragma unroll
  for (int r = 0; r < 16; ++r) p1[r] = __builtin_amdgcn_exp2f(fmaf(p1[r], C, mnC));
}
__device__ __forceinline__ void finishSM(f32x16& p0, f32x16& p1, float alpha, float& l_reg, bf16x8& pa0, bf16x8& pa1, bf16x8& pa2, bf16x8& pa3) {
  float ps = 0;
#pragma unroll
  for (int r = 0; r < 16; ++r) ps += p0[r];
#pragma unroll
  for (int r = 0; r < 16; ++r) ps += p1[r];
  { auto rr = __builtin_amdgcn_permlane32_swap(__float_as_uint(ps), __float_as_uint(ps), false, false);
    ps = __uint_as_float(rr[0]) + __uint_as_float(rr[1]); }
  l_reg = l_reg * alpha + ps;
  PK4(p0, 0, pa0); PK4(p0, 8, pa1); PK4(p1, 0, pa2); PK4(p1, 8, pa3);
}
__device__ __forceinline__ int v_st(int k, int c) { const int kk = (k & ~0xC) | ((k & 4) << 1) | ((k & 8) >> 1); return ((kk >> 3) * 4 + (c >> 5)) * 512 + ((kk & 7) * 32 + (c & 31)) * 2; }
__device__ __forceinline__ int v_rd_base(int lane) { return ((lane & 3) << 3) | (((lane >> 2) & 3) << 6) | (((lane >> 4) & 1) << 5) | (((lane >> 5) & 1) << 8); }
constexpr int v_rd_off(int d0, int ks, int half) { return d0 * 512 + ks * 4096 + half * 2048; }
template <int OFF> __device__ __forceinline__ s16x4 tr_read(int vb) {
  s16x4 r; asm volatile("ds_read_b64_tr_b16 %0, %1 offset:%2" : "=&v"(r) : "v"(vb), "i"(OFF) : "memory"); return r;
}
template <int D0> __device__ __forceinline__ void pv_one(f32x16& od, int vb, bf16x8 pa0, bf16x8 pa1, bf16x8 pa2, bf16x8 pa3) {
#define PKV(L, H) (bf16x8){L[0], L[1], L[2], L[3], H[0], H[1], H[2], H[3]}
  { const s16x4 l0 = tr_read<v_rd_off(D0, 0, 0)>(vb), h0 = tr_read<v_rd_off(D0, 0, 1)>(vb), l1 = tr_read<v_rd_off(D0, 1, 0)>(vb), h1 = tr_read<v_rd_off(D0, 1, 1)>(vb);
    asm volatile("s_waitcnt lgkmcnt(0)" ::: "memory"); SBAR();
    od = MFMA(pa0, PKV(l0, h0), od); od = MFMA(pa1, PKV(l1, h1), od); }
  { const s16x4 l2 = tr_read<v_rd_off(D0, 2, 0)>(vb), h2 = tr_read<v_rd_off(D0, 2, 1)>(vb), l3 = tr_read<v_rd_off(D0, 3, 0)>(vb), h3 = tr_read<v_rd_off(D0, 3, 1)>(vb);
    asm volatile("s_waitcnt lgkmcnt(0)" ::: "memory"); SBAR();
    od = MFMA(pa2, PKV(l2, h2), od); od = MFMA(pa3, PKV(l3, h3), od); }
#undef PKV
}
template <int D0> __device__ __forceinline__ void pv_two(f32x16& oa, f32x16& ob, int vb, bf16x8 a0, bf16x8 a1, bf16x8 a2, bf16x8 a3,
                                                         bf16x8 b0, bf16x8 b1, bf16x8 b2, bf16x8 b3) {
#define PKV(L, H) (bf16x8){L[0], L[1], L[2], L[3], H[0], H[1], H[2], H[3]}
  { const s16x4 l0 = tr_read<v_rd_off(D0, 0, 0)>(vb), h0 = tr_read<v_rd_off(D0, 0, 1)>(vb), l1 = tr_read<v_rd_off(D0, 1, 0)>(vb), h1 = tr_read<v_rd_off(D0, 1, 1)>(vb);
    asm volatile("s_waitcnt lgkmcnt(0)" ::: "memory"); SBAR();
    const bf16x8 v0 = PKV(l0, h0), v1 = PKV(l1, h1);
    oa = MFMA(a0, v0, oa); ob = MFMA(b0, v0, ob); oa = MFMA(a1, v1, oa); ob = MFMA(b1, v1, ob); }
  { const s16x4 l2 = tr_read<v_rd_off(D0, 2, 0)>(vb), h2 = tr_read<v_rd_off(D0, 2, 1)>(vb), l3 = tr_read<v_rd_off(D0, 3, 0)>(vb), h3 = tr_read<v_rd_off(D0, 3, 1)>(vb);
    asm volatile("s_waitcnt lgkmcnt(0)" ::: "memory"); SBAR();
    const bf16x8 v2 = PKV(l2, h2), v3 = PKV(l3, h3);
    oa = MFMA(a2, v2, oa); ob = MFMA(b2, v2, ob); oa = MFMA(a3, v3, oa); ob = MFMA(b3, v3, ob); }
#undef PKV
}
constexpr int ATT_KB = 8192, ATT_VB = 16384, NTILE = SEQ / 64;
__device__ __forceinline__ void att_qkt(f32x16& p0, f32x16& p1, const char* Kb, const bf16x8 (&qr)[4], int koff, int ksw, int hi) {
  p0 = f32x16{}; p1 = f32x16{};
#pragma unroll
  for (int d0 = 0; d0 < 4; ++d0) {
    const int co = ((d0 * 2 + hi) ^ ksw) << 4;
    const bf16x8 b0 = *(const bf16x8*)(Kb + koff + co);
    const bf16x8 b1 = *(const bf16x8*)(Kb + koff + 4096 + co);
    p0 = MFMA(b0, qr[d0], p0); p1 = MFMA(b1, qr[d0], p1);
  }
}
__device__ __forceinline__ void sm_fixed(f32x16& p0, f32x16& p1, float mC, float& l_reg, bf16x8& pa0, bf16x8& pa1, bf16x8& pa2, bf16x8& pa3) {
  constexpr float C = 1.4426950408889634f;
#pragma unroll
  for (int r = 0; r < 16; ++r) p0[r] = __builtin_amdgcn_exp2f(fmaf(p0[r], C, -mC));
#pragma unroll
  for (int r = 0; r < 16; ++r) p1[r] = __builtin_amdgcn_exp2f(fmaf(p1[r], C, -mC));
  float ps = 0;
#pragma unroll
  for (int r = 0; r < 16; ++r) ps += p0[r];
#pragma unroll
  for (int r = 0; r < 16; ++r) ps += p1[r];
  { auto rr = __builtin_amdgcn_permlane32_swap(__float_as_uint(ps), __float_as_uint(ps), false, false);
    ps = __uint_as_float(rr[0]) + __uint_as_float(rr[1]); }
  l_reg += ps;
#define PK4N(PV, BASE, OUT) do { u32x4 w_ = {cvtpk(PV[BASE + 0], PV[BASE + 1]), cvtpk(PV[BASE + 2], PV[BASE + 3]), \
    cvtpk(PV[BASE + 4], PV[BASE + 5]), cvtpk(PV[BASE + 6], PV[BASE + 7])}; OUT = *reinterpret_cast<bf16x8*>(&w_); } while (0)
  PK4N(p0, 0, pa0); PK4N(p0, 8, pa1); PK4N(p1, 0, pa2); PK4N(p1, 8, pa3);
#undef PK4N
}
__device__ __forceinline__ float sumsq8(bf16x8 v) { float s = 0.f;
#pragma unroll
  for (int q = 0; q < 8; ++q) { const float f = bf2f((u16)v[q]); s += f * f; } return s; }
__device__ __forceinline__ void att_qkt_p(f32x16& p0, f32x16& p1, const char* Kb, const bf16x8 (&qr)[2], const char* Qp, int koff, int ksw, int hi) {
  p0 = f32x16{}; p1 = f32x16{};
#pragma unroll
  for (int d0 = 0; d0 < 4; ++d0) {
    const int co = ((d0 * 2 + hi) ^ ksw) << 4;
    const bf16x8 b0 = *(const bf16x8*)(Kb + koff + co);
    const bf16x8 b1 = *(const bf16x8*)(Kb + koff + 4096 + co);
    const bf16x8 qd = d0 < 2 ? qr[d0 & 1] : *(const bf16x8*)(Qp + (d0 - 2) * 4096);
    p0 = MFMA(b0, qd, p0); p1 = MFMA(b1, qd, p1);
  }
}
__device__ __forceinline__ void attn_item(const P& p, int layer, int item, char* lds) {
  const int tid = ltid(), wid = tid >> 6, lane = tid & 63, r32 = lane & 31, hi = lane >> 5;
  const int qb = item & 63, h = (item >> 6) & 3, b = item >> 8;
  const u16* z = (const u16*)(p.ws + OFF_Z);
  const long tokb = (long)b * SEQ, tokq = tokb + qb * 128;
  constexpr int STG = 2 * ATT_KB + ATT_VB;
  float* wsf = (float*)(lds + 2 * STG) + wid * 64;
  float* li_l = wsf; float* al_l = wsf + 32;
  const int vb0 = (int)(uintptr_t)(lds + 2 * ATT_KB) + v_rd_base(lane);
  const int koff = r32 * 128, ksw = (r32 >> 1) & 7;
  const unsigned k_src = (tid >> 3) * ZC + (((tid & 7) ^ ((tid >> 4) & 7)) << 3);
  const int v_kl = (tid & 31) >> 2;
  const unsigned v_src = (v_kl | ((tid >> 7) << 3)) * ZC + ((tid >> 5) & 3) * 32 + (tid & 3) * 8;
  char* lw = lds + tid * 16;
  const float lam = ((const float*)(p.ws + OFF_LAM))[layer];
  const u16* Kg = z + tokb * ZC + C_DAK + h * 128; const u16* Vg = z + tokb * ZC + C_DAV + h * 128;
  bf16x8 q1[4], q2[2];
  char* Qp = lds + 2 * STG + 1024 + tid * 16;
#pragma unroll
  for (int d0 = 0; d0 < 4; ++d0) q1[d0] = *(const bf16x8*)(z + (tokq + wid * 32 + r32) * ZC + h * 128 + d0 * 16 + hi * 8);
#pragma unroll
  for (int d0 = 0; d0 < 2; ++d0) q2[d0] = *(const bf16x8*)(z + (tokq + wid * 32 + r32) * ZC + h * 128 + 64 + d0 * 16 + hi * 8);
  __syncthreads();
  float qs1 = 0.f, qs2 = 0.f;
#pragma unroll
  for (int d0 = 0; d0 < 4; ++d0) qs1 += sumsq8(q1[d0]);
#pragma unroll
  for (int d0 = 0; d0 < 2; ++d0) qs2 += sumsq8(q2[d0]);
#pragma unroll
  for (int d0 = 2; d0 < 4; ++d0) { const bf16x8 t = *(const bf16x8*)(z + (tokq + wid * 32 + r32) * ZC + h * 128 + 64 + d0 * 16 + hi * 8);
    qs2 += sumsq8(t); *(bf16x8*)(Qp + (d0 - 2) * 4096) = t; }
  { auto rr = __builtin_amdgcn_permlane32_swap(__float_as_uint(qs1), __float_as_uint(qs1), false, false); qs1 = __uint_as_float(rr[0]) + __uint_as_float(rr[1]); }
  { auto rr = __builtin_amdgcn_permlane32_swap(__float_as_uint(qs2), __float_as_uint(qs2), false, false); qs2 = __uint_as_float(rr[0]) + __uint_as_float(rr[1]); }
  float mC1, mC2;
  { const float* kmx = (const float*)(p.ws + OFF_KMX) + (size_t)((b * 4 + h) * 2) * 128;
    float k1 = fmaxf(kmx[lane], kmx[64 + lane]), k2 = fmaxf(kmx[128 + lane], kmx[192 + lane]);
#pragma unroll
    for (int o = 32; o >= 1; o >>= 1) { k1 = fmaxf(k1, __shfl_xor(k1, o)); k2 = fmaxf(k2, __shfl_xor(k2, o)); }
    mC1 = sqrtf(qs1 * k1) * 1.4426950408889634f; mC2 = sqrtf(qs2 * k2) * 1.4426950408889634f; }
  float l1 = 0.f, l2 = 0.f;
  f32x16 o1[4], o2[4];
#pragma unroll
  for (int d = 0; d < 4; ++d) { o1[d] = f32x16{}; o2[d] = f32x16{}; }
#define ISSUE_T(t, sl) do { char* S_ = lw + (sl) * STG; \
    _Pragma("unroll") for (int i_ = 0; i_ < 2; ++i_) { glds16(Kg + (long)((t) * 64 + 32 * i_) * ZC + k_src, S_ + i_ * 4096); \
                                                        glds16(Kg + 64 + (long)((t) * 64 + 32 * i_) * ZC + k_src, S_ + ATT_KB + i_ * 4096); } \
    _Pragma("unroll") for (int i_ = 0; i_ < 4; ++i_) glds16(Vg + (long)((t) * 64 + 16 * i_) * ZC + v_src, S_ + 2 * ATT_KB + i_ * 4096); } while (0)
#define RESC(a, O) do { if (__any((a) < 1.f)) { if (hi == 0) al_l[r32] = (a); asm volatile("s_waitcnt lgkmcnt(0)" ::: "memory"); \
    _Pragma("unroll") for (int d_ = 0; d_ < 4; ++d_) _Pragma("unroll") for (int r_ = 0; r_ < 16; ++r_) O[d_][r_] *= al_l[crow(r_, hi)]; } } while (0)
#define MAPSTEP(QKT, MC, L, PA0, PA1, PA2, PA3) do { f32x16 p0, p1; \
    QKT; \
    sm_fixed(p0, p1, MC, L, PA0, PA1, PA2, PA3); } while (0)
  __syncthreads();
  ISSUE_T(0, 0);
  for (int j = 0; j < NTILE; ++j) {
    asm volatile("s_waitcnt vmcnt(0)" ::: "memory"); __syncthreads();
    if (j + 1 < NTILE) ISSUE_T(j + 1, (j + 1) & 1);
    const char* S = lds + (j & 1) * STG;
    const int vb = vb0 + (j & 1) * STG;
    bf16x8 pa0, pa1, pa2, pa3, pb0, pb1, pb2, pb3;
    MAPSTEP(att_qkt(p0, p1, S, q1, koff, ksw, hi), mC1, l1, pa0, pa1, pa2, pa3);
    SBAR();
    MAPSTEP(att_qkt_p(p0, p1, S + ATT_KB, q2, Qp, koff, ksw, hi), mC2, l2, pb0, pb1, pb2, pb3);
    SBAR();
    pv_two<0>(o1[0], o2[0], vb, pa0, pa1, pa2, pa3, pb0, pb1, pb2, pb3); pv_two<1>(o1[1], o2[1], vb, pa0, pa1, pa2, pa3, pb0, pb1, pb2, pb3);
    pv_two<2>(o1[2], o2[2], vb, pa0, pa1, pa2, pa3, pb0, pb1, pb2, pb3); pv_two<3>(o1[3], o2[3], vb, pa0, pa1, pa2, pa3, pb0, pb1, pb2, pb3);
  }
#undef MAPSTEP
#undef RESC
#undef ISSUE_T
  float r1[16], r2[16];
  if (hi == 0) li_l[r32] = l1;
  asm volatile("s_waitcnt lgkmcnt(0)" ::: "memory");
#pragma unroll
  for (int r = 0; r < 16; ++r) r1[r] = 1.f / li_l[crow(r, hi)];
  asm volatile("s_waitcnt lgkmcnt(0)" ::: "memory");
  if (hi == 0) li_l[r32] = l2;
  asm volatile("s_waitcnt lgkmcnt(0)" ::: "memory");
#pragma unroll
  for (int r = 0; r < 16; ++r) r2[r] = lam / li_l[crow(r, hi)];
  const int oz = opq();
  const float gsc = ((const float*)(p.ws + OFF_LAM))[2 + layer];
  float sg[4];
#pragma unroll
  for (int d = 0; d < 4; ++d) sg[d] = p.subln[layer * 128 + d * 32 + r32] * gsc;
  u16* ymix = (u16*)(p.ws + OFF_YMIX);
  const unsigned yb = (unsigned)(tokq + wid * 32 + 4 * hi + oz) * 1024 + h * 128 + r32;
#pragma unroll
  for (int r = 0; r < 16; ++r) {
    float v[4]; float ss = 0.f;
#pragma unroll
    for (int d = 0; d < 4; ++d) { v[d] = o1[d][r] * r1[r] - o2[d][r] * r2[r]; ss += v[d] * v[d]; }
    ss = half_sum32(ss);
    const float rs = rsqrtf(ss * (1.f / 128.f) + 1e-6f);
#pragma unroll
    for (int d = 0; d < 4; ++d) ymix[yb + (unsigned)((r & 3) + 8 * (r >> 2)) * 1024 + d * 32] = f2bf(v[d] * rs * sg[d]);
    if ((r & 3) == 3) SBAR();
  }
}

__device__ __forceinline__ void phase_wout(const P& p, int layer, char* lds) {
  const u16* ym = (const u16*)(p.ws + OFF_YMIX); const u16* wt = (const u16*)(p.ws + OFF_WOUT + layer * SZ_WOUT);
  const u16* xbr = (const u16*)(p.ws + OFF_XB);
  const int lane = ltid() & 63, wid = ltid() >> 6, wr = wid >> 1, wc = wid & 1, r32 = lane & 31, hi = lane >> 5;
  int tm, tn;
  for (int it = 0; tile_at(it, 256, 8, tm, tn); ++it) {
    f32x16 acc[2][2] = {};
    LdBf al{ym + (long)tm * 128 * 1024, 1024}, bl{wt + (long)tn * 128 * 1024, 1024};
    gemm_plain(acc, al, bl, 1024, lds);
    const unsigned rb = (unsigned)(tm * 128 + wr * 64 + 4 * hi + opq());
    _Float16* pre1 = (_Float16*)(p.ws + OFF_PRE1);
#pragma unroll
    for (int mi = 0; mi < 2; ++mi) {
      float xr[2][16];
      if (layer == 0) {
#pragma unroll
        for (int ni = 0; ni < 2; ++ni)
#pragma unroll
          for (int r = 0; r < 16; ++r) xr[ni][r] = p.x[(rb + mi * 32 + (r & 3) + 8 * (r >> 2)) * DM + tn * 128 + wc * 64 + ni * 32 + r32];
      } else {
#pragma unroll
        for (int ni = 0; ni < 2; ++ni)
#pragma unroll
          for (int r = 0; r < 16; ++r) xr[ni][r] = bf2f(xbr[(rb + mi * 32 + (r & 3) + 8 * (r >> 2)) * DM + tn * 128 + wc * 64 + ni * 32 + r32]);
      }
#pragma unroll
      for (int ni = 0; ni < 2; ++ni)
#pragma unroll
        for (int r = 0; r < 16; ++r) {
          const unsigned row = rb + mi * 32 + (r & 3) + 8 * (r >> 2); const unsigned col = tn * 128 + wc * 64 + ni * 32 + r32;
          pre1[row * DM + col] = (_Float16)(ALPHA * xr[ni][r] + acc[mi][ni][r]);
        }
      SBAR();
    }
  }
}
__device__ __forceinline__ float4 ldh4(const _Float16* q) {
  typedef _Float16 h4_ __attribute__((ext_vector_type(4)));
  const h4_ t = __builtin_nontemporal_load((const h4_*)q); return float4{(float)t[0], (float)t[1], (float)t[2], (float)t[3]};
}
__device__ __forceinline__ void phase_ln(const P& p, const float* g, const float* bta, const float* pconv, bool write_f32, const _Float16* pre) {
  const int lane = ltid() & 63, wid = ltid() >> 6;
  u16* xb = (u16*)(p.ws + OFF_XB);
  if (pconv) {
    u16* pb = (u16*)(p.ws + OFF_PB);
    for (long i = (long)blockIdx.x * NTHR + ltid(); i < (long)TT * 256 / 8; i += (long)gridDim.x * NTHR) {
      const float4* q = (const float4*)(pconv + i * 8); float4 a = ntld4(q), b = ntld4(q + 1);
      u32x4 w = {cvtpk(a.x, a.y), cvtpk(a.z, a.w), cvtpk(b.x, b.y), cvtpk(b.z, b.w)};
      *(u32x4*)(pb + i * 8) = w; }
  }
  const long rstride = (long)gridDim.x * 4;
  float4 gg4[4], bb4[4];
#pragma unroll
  for (int i = 0; i < 4; ++i) { gg4[i] = *(const float4*)(g + (i * 64 + lane) * 4); bb4[i] = *(const float4*)(bta + (i * 64 + lane) * 4); }
  for (long row0 = (long)blockIdx.x * 4 + wid; row0 < TT; row0 += 2 * rstride) {
    const long row1 = row0 + rstride; const bool two = row1 < TT;
    float4 v[2][4]; float s[2] = {0.f, 0.f};
#pragma unroll
    for (int i = 0; i < 4; ++i) { v[0][i] = ldh4(pre + row0 * DM + (i * 64 + lane) * 4); s[0] += v[0][i].x + v[0][i].y + v[0][i].z + v[0][i].w; }
    if (two) {
#pragma unroll
      for (int i = 0; i < 4; ++i) { v[1][i] = ldh4(pre + row1 * DM + (i * 64 + lane) * 4); s[1] += v[1][i].x + v[1][i].y + v[1][i].z + v[1][i].w; }
    } else {
#pragma unroll
      for (int i = 0; i < 4; ++i) v[1][i] = float4{0.f, 0.f, 0.f, 0.f};
    }
#pragma unroll
    for (int u = 0; u < 2; ++u) {
      if (u == 1 && !two) break;
      const long row = u ? row1 : row0;
      const float mu = wave_sum(s[u]) * (1.f / 1024.f);
      float q = 0.f;
#pragma unroll
      for (int i = 0; i < 4; ++i) { v[u][i].x -= mu; v[u][i].y -= mu; v[u][i].z -= mu; v[u][i].w -= mu; q += v[u][i].x * v[u][i].x + v[u][i].y * v[u][i].y + v[u][i].z * v[u][i].z + v[u][i].w * v[u][i].w; }
      const float rs = rsqrtf(wave_sum(q) * (1.f / 1024.f) + 1e-5f);
#pragma unroll
      for (int i = 0; i < 4; ++i) {
        const int c = (i * 64 + lane) * 4;
        const float4 gg = gg4[i], bb = bb4[i];
        float4 y = {v[u][i].x * rs * gg.x + bb.x, v[u][i].y * rs * gg.y + bb.y, v[u][i].z * rs * gg.z + bb.z, v[u][i].w * rs * gg.w + bb.w};
        if (write_f32) *(float4*)(p.out + row * DM + c) = y;
        u32x2 w = {cvtpk(y.x, y.y), cvtpk(y.z, y.w)};
        *(u32x2*)(xb + row * DM + c) = w;
      }
    }
  }
}
__device__ __forceinline__ void phase_ffn_up(const P& p, int layer, char* lds) {
  const u16* xb = (const u16*)(p.ws + OFF_XB); const u16* wt = (const u16*)(p.ws + OFF_WUP + layer * SZ_WUP);
  u16* aout = (u16*)(p.ws + OFF_A);
  const int tid = ltid(), lane = tid & 63, wid = tid >> 6, wr = wid >> 1, wc = wid & 1, r32 = lane & 31, hi = lane >> 5;
  float* G = (float*)lds;
  int tm, tn;
  for (int it = 0; tile_at(it, 256, 44, tm, tn); ++it) {
    f32x16 acc[2][2] = {}; f32x16 hacc = {};
    const long r0 = (long)tm * 128;
    const bool top0 = (r0 % SEQ) == 0, bot0 = ((r0 + 128) % SEQ) == 0;
    LdBf al{xb + r0 * DM, DM}; LdBsplit bl{wt, DM, tn * 64};
    const u16* zr = (const u16*)(p.ws + OFF_ZERO);
    const u16* h0 = top0 ? zr : xb + (r0 - 1) * DM; const u16* h1 = bot0 ? zr : xb + (r0 + 128) * DM;
    gemm_core<true>(acc, hacc, al, bl, DM, lds, h0, h1, wc * 32, 64 + wc * 32);
    __syncthreads();
    const int lb0 = wr * 64 + 4 * hi + opq();
    float* Gc = G + wc * 32 + r32;
#pragma unroll
    for (int mi = 0; mi < 2; ++mi)
#pragma unroll
      for (int r = 0; r < 16; ++r) Gc[(1 + lb0 + mi * 32 + (r & 3) + 8 * (r >> 2)) * 65] = acc[mi][0][r];
    if (hi == 0) { if (wr == 0) Gc[0] = hacc[0]; else Gc[129 * 65] = hacc[1]; }
    __syncthreads();
    const int f = tn * 64 + wc * 32 + r32;
    const float w0 = p.conv_w[(layer * 3 + 0) * DFF + f], w1 = p.conv_w[(layer * 3 + 1) * DFF + f], w2 = p.conv_w[(layer * 3 + 2) * DFF + f];
    const float cb = p.conv_b[layer * DFF + f];
    const unsigned ob = (unsigned)(tm * 128) * DFF + f;
#pragma unroll
    for (int mi = 0; mi < 2; ++mi) {
      float gp[16], gn[16];
#pragma unroll
      for (int r = 0; r < 16; ++r) { const int lr = lb0 + mi * 32 + (r & 3) + 8 * (r >> 2); gp[r] = Gc[lr * 65]; gn[r] = Gc[(lr + 2) * 65]; }
#pragma unroll
      for (int r = 0; r < 16; r += 2) {
        const int lr = lb0 + mi * 32 + (r & 3) + 8 * (r >> 2);
        const float g0 = fmaf(w0, gp[r], fmaf(w1, acc[mi][0][r], fmaf(w2, gn[r], cb)));
        const float g1 = fmaf(w0, gp[r + 1], fmaf(w1, acc[mi][0][r + 1], fmaf(w2, gn[r + 1], cb)));
        const unsigned w = cvtpk(gelu_t(g0) * acc[mi][1][r], gelu_t(g1) * acc[mi][1][r + 1]);
        aout[ob + (unsigned)lr * DFF] = (u16)w; aout[ob + (unsigned)(lr + 1) * DFF] = (u16)(w >> 16);
      }
      SBAR();
    }
  }
}
__device__ __forceinline__ void phase_ffn_down(const P& p, int layer, char* lds) {
  const u16* xb = (const u16*)(p.ws + OFF_XB); const u16* ab = (const u16*)(p.ws + OFF_A);
  const u16* wd = (const u16*)(p.ws + OFF_WDN + layer * SZ_WDN); const u16* wg = (const u16*)(p.ws + OFF_WGATE + layer * SZ_WGATE);
  const u16* wp = (const u16*)(p.ws + OFF_WPLE + layer * SZ_WPLE);
  const u16* pb = (const u16*)(p.ws + OFF_PB);
  const int lane = ltid() & 63, wid = ltid() >> 6, wr = wid >> 1, wc = wid & 1, r32 = lane & 31, hi = lane >> 5;
  int tm, tn;
  for (int it = 0; tile_at(it, 256, 8, tm, tn); ++it) {
    f32x16 acc[2][2] = {};
    { LdBf al{xb + (long)tm * 128 * DM, DM}, bl{wg + (long)tn * 128 * DM, DM}; gemm_plain(acc, al, bl, DM, lds); }
#pragma unroll
    for (int mi = 0; mi < 2; ++mi)
#pragma unroll
      for (int ni = 0; ni < 2; ++ni)
#pragma unroll
        for (int r = 0; r < 16; ++r) acc[mi][ni][r] = sigmoidf_(acc[mi][ni][r]);
    f32x16 acc2[2][2] = {};
    { LdBf al{pb + (long)tm * 128 * 256, 256}; LdBf bl{wp + (long)tn * 128 * 256, 256}; gemm_plain(acc2, al, bl, 256, lds); }
#pragma unroll
    for (int mi = 0; mi < 2; ++mi)
#pragma unroll
      for (int ni = 0; ni < 2; ++ni) acc[mi][ni] = acc[mi][ni] * acc2[mi][ni];
    { LdBf al{ab + (long)tm * 128 * DFF, DFF}, bl{wd + (long)tn * 128 * DFF, DFF}; gemm_plain(acc, al, bl, DFF, lds); }
    const unsigned rb = (unsigned)(tm * 128 + wr * 64 + 4 * hi + opq());
#pragma unroll
    for (int mi = 0; mi < 2; ++mi) {
#pragma unroll
      for (int ni = 0; ni < 2; ++ni)
#pragma unroll
        for (int r = 0; r < 16; ++r) {
          const unsigned row = rb + mi * 32 + (r & 3) + 8 * (r >> 2); const unsigned col = tn * 128 + wc * 64 + ni * 32 + r32;
          ((_Float16*)(p.ws + OFF_PRE2))[row * DM + col] = (_Float16)(ALPHA * bf2f(xb[row * DM + col]) + acc[mi][ni][r]);
        }
      SBAR();
    }
  }
}

#define XB_TMO      128
#define XB_XCNT(j)  (256  + 64 * (j))
#define XB_XSUB(j)  (1280 + 64 * (j))
#define XB_XGEN(j)  (2304 + 64 * (j))
#define XB_TOP      3328
#define XB_TOPGEN   3392
#define XB_SPIN_CAP (1u << 20)
#define LAS __attribute__((address_space(3)))
__device__ __forceinline__ unsigned xb_ld(unsigned* p)              { return __hip_atomic_load(p, __ATOMIC_RELAXED, __HIP_MEMORY_SCOPE_AGENT); }
__device__ __forceinline__ unsigned xb_add(unsigned* p, unsigned v) { return __hip_atomic_fetch_add(p, v, __ATOMIC_RELAXED, __HIP_MEMORY_SCOPE_AGENT); }
__device__ __forceinline__ unsigned xb_xcc_id() { return (unsigned)__builtin_amdgcn_s_getreg((3 << 11) | 20) & 0xFu; }
#define XB_SPIN(cond, bar) do { unsigned _sp = 0; while (cond) { __builtin_amdgcn_s_sleep(1); \
    if ((++_sp & 255u) == 0u) { if (xb_ld(&(bar)[XB_TMO])) break; if (_sp > XB_SPIN_CAP) { atomicAdd(&(bar)[XB_TMO], 1u); break; } } } } while (0)
struct XcdBarrier { unsigned* bar; unsigned x; volatile LAS unsigned* st; };
__device__ __forceinline__ XcdBarrier xcd_barrier_post(unsigned* bar, volatile LAS unsigned* st) {
  XcdBarrier b; b.bar = bar; b.x = xb_xcc_id(); b.st = st;
  if (threadIdx.x == 0) (void)xb_add(&bar[XB_XCNT(b.x)], 1u);
  return b;
}
__device__ __forceinline__ void xcd_barrier_complete(unsigned* bar, unsigned x, unsigned& nloc, unsigned& nx) {
  const unsigned G = gridDim.x * gridDim.y * gridDim.z;
  unsigned sum, cnt, mine, sp = 0u;
  for (;;) {
    sum = 0u; cnt = 0u; mine = 0u;
#pragma unroll
    for (unsigned j = 0; j < 16; ++j) { const unsigned c = xb_ld(&bar[XB_XCNT(j)]); sum += c; cnt += (c > 0u) ? 1u : 0u; mine = (j == x) ? c : mine; }
    if (sum == G) break;
    __builtin_amdgcn_s_sleep(1);
    if ((++sp & 255u) == 0u) { if (xb_ld(&bar[XB_TMO])) break; if (sp > XB_SPIN_CAP) { atomicAdd(&bar[XB_TMO], 1u); break; } }
  }
  nloc = mine > 0u ? mine : 1u; nx = cnt > 0u ? cnt : 1u;
}
__device__ __forceinline__ void xcd_barrier(const XcdBarrier& b) {
  asm volatile("s_waitcnt vmcnt(0)" ::: "memory");
  __syncthreads();
  if (threadIdx.x == 0) {
    unsigned* bar = b.bar;
    __builtin_amdgcn_s_waitcnt(0);
    unsigned nloc = b.st[0], nx = b.st[1];
    if (nloc == 0u) { xcd_barrier_complete(bar, b.x, nloc, nx); b.st[0] = nloc; b.st[1] = nx; }
    const unsigned old = xb_add(&bar[XB_XSUB(b.x)], 1u);
    const unsigned gen = old / nloc;
    if (old + 1u == (gen + 1u) * nloc) {
      __builtin_amdgcn_fence(__ATOMIC_RELEASE, "agent");
      asm volatile("s_waitcnt vmcnt(0)" ::: "memory");
      const unsigned og = xb_add(&bar[XB_TOP], 1u);
      const unsigned tg = og / nx;
      if (og + 1u == (tg + 1u) * nx) xb_add(&bar[XB_TOPGEN], 1u);
      else XB_SPIN(xb_ld(&bar[XB_TOPGEN]) == tg, bar);
      __builtin_amdgcn_fence(__ATOMIC_ACQUIRE, "agent");
      xb_add(&bar[XB_XGEN(b.x)], 1u);
      asm volatile("s_waitcnt vmcnt(0)" ::: "memory");
    } else {
      XB_SPIN(xb_ld(&bar[XB_XGEN(b.x)]) == gen, bar);
      __builtin_amdgcn_fence(__ATOMIC_ACQUIRE, "agent");
      asm volatile("s_waitcnt vmcnt(0)" ::: "memory");
    }
  }
  __syncthreads();
}

constexpr int NSUB = 10, NPH = 1 + 2 * NSUB;
template <bool WITH_P0>
__device__ __forceinline__ void run_phase(const P& pin, int ph, char* lds) {
  typedef const __attribute__((address_space(4))) P* KP;
  KP kp = (KP)__builtin_amdgcn_kernarg_segment_ptr();
  asm volatile("" : "+s"(kp));
  P p;
  p.x = kp->x;
  p.p = kp->p;
  p.pos = kp->pos;
  p.w_in = kp->w_in;
  p.lq1 = kp->lq1;
  p.lk1 = kp->lk1;
  p.lq2 = kp->lq2;
  p.lk2 = kp->lk2;
  p.subln = kp->subln;
  p.gn_g = kp->gn_g;
  p.gn_b = kp->gn_b;
  p.A_re = kp->A_re;
  p.A_im = kp->A_im;
  p.log_dt = kp->log_dt;
  p.B_re = kp->B_re;
  p.B_im = kp->B_im;
  p.C_re = kp->C_re;
  p.C_im = kp->C_im;
  p.Dp = kp->Dp;
  p.glu_w = kp->glu_w;
  p.glu_b = kp->glu_b;
  p.w_out = kp->w_out;
  p.ln1g = kp->ln1g;
  p.ln1b = kp->ln1b;
  p.w_up = kp->w_up;
  p.conv_w = kp->conv_w;
  p.conv_b = kp->conv_b;
  p.w_down = kp->w_down;
  p.ple_w = kp->ple_w;
  p.gate_w = kp->gate_w;
  p.ln2g = kp->ln2g;
  p.ln2b = kp->ln2b;
  p.out = kp->out;
  p.ws = kp->ws;

  if (ph == 0) { if (WITH_P0) phase0(p, lds); return; }
  const int layer = (ph - 1) / NSUB, s = (ph - 1) % NSUB;
  const int bid = blockIdx.x, nb = gridDim.x;
  switch (s) {
    case 0: phase_z(p, layer, lds); if (layer == 0) s5_build_ktab_F(p); break;
    case 1:
      for (int t = bid; t < 1024; t += nb) ret_kv_item(p, t, lds);
      for (int t = bid; t < 256; t += nb) s5_state_tile(p, layer, t, lds);
      if (layer == 0) s5_build_M(p);
      break;
    case 2: s5_scan(p, layer); ret_scan(p); break;
    case 3: {
      const int x = bid & 7, lb = bid >> 3, nlb = nb >> 3;
      for (int t = bid; t < 1024; t += nb) ret_out_item(p, layer, t, lds);
      for (int t = bid; t < 512; t += nb) s5_out_tile(p, layer, t, lds);
      for (int i = lb; i < 128; i += nlb) attn_item(p, layer, (i >> 6) * 512 + x * 64 + (i & 63), lds);
    } break;
    case 4: phase_glu(p, layer, lds); break;
    case 5: phase_wout(p, layer, lds); break;
    case 6: phase_ln(p, p.ln1g + layer * DM, p.ln1b + layer * DM, p.p + (size_t)layer * TT * 256, false, (const _Float16*)(p.ws + OFF_PRE1)); break;
    case 7: phase_ffn_up(p, layer, lds); break;
    case 8: phase_ffn_down(p, layer, lds); break;
    default: phase_ln(p, p.ln2g + layer * DM, p.ln2b + layer * DM, nullptr, layer == 1, (const _Float16*)(p.ws + OFF_PRE2)); break;
  }
}

__global__ void __launch_bounds__(NTHR, 2) mega(P p, int ph0, int ph1) {
  extern __shared__ __attribute__((aligned(16))) char lds[];
  if (ph1 < 0) cg::this_grid().sync();
  volatile LAS unsigned* st = (volatile LAS unsigned*)(lds + LDS_BYTES);
  if (threadIdx.x == 0) { st[0] = 0u; st[1] = 0u; st[2] = 0u; st[3] = 0u; }
  __syncthreads();
  const XcdBarrier xb = xcd_barrier_post((unsigned*)(p.ws + OFF_BAR), st);
#define GSYNC() xcd_barrier(xb)
  for (int i = 0; i < PROBE_SYNCS; ++i) GSYNC();
  int ph = ph0;
  if (ph == 0) {
    const int nrep0 = 1 + ((PROBE_MASK >> NSUB) & 1);
    for (int rep = 0; rep < nrep0; ++rep) { run_phase<true>(p, 0, lds); if (rep + 1 < nrep0 || 1 < ph1) GSYNC(); }
    ph = 1;
  }
  for (; ph < ph1; ++ph) {
    const int nrep = 1 + ((PROBE_MASK >> ((ph - 1) % NSUB)) & 1);
    for (int rep = 0; rep < nrep; ++rep) {
      run_phase<false>(p, ph, lds);
      if (rep + 1 < nrep || ph + 1 < ph1) GSYNC();
    }
  }
#undef GSYNC
}

extern "C" void kernel_launch(void* const* d_in, const int* in_sizes, int n_in, void* d_out, int out_size,
                              void* d_ws, size_t ws_size, hipStream_t stream) {
  static int grid_blocks = 0;
  if (!grid_blocks) {
    int dev = 0, cus = 0, per_cu = 0;
    (void)hipGetDevice(&dev);
    (void)hipDeviceGetAttribute(&cus, hipDeviceAttributeMultiprocessorCount, dev);
    (void)hipFuncSetAttribute((const void*)mega, hipFuncAttributeMaxDynamicSharedMemorySize, LDS_TOTAL);
    (void)hipOccupancyMaxActiveBlocksPerMultiprocessor(&per_cu, mega, NTHR, LDS_TOTAL);
    if (per_cu > 2) per_cu = 2;
    if (per_cu < 1) per_cu = 1;
    grid_blocks = cus * per_cu;
    grid_blocks -= grid_blocks % 8;
    if (ws_size < WS_NEED) fprintf(stderr, "kernel_launch: workspace too small: %zu < %zu\n", ws_size, WS_NEED);
  }
  if (ws_size < WS_NEED || n_in < 32) return;
  P p{};
  p.x = (const float*)d_in[0]; p.p = (const float*)d_in[1]; p.pos = (const int*)d_in[2];
  p.w_in = (const float*)d_in[3]; p.lq1 = (const float*)d_in[4]; p.lk1 = (const float*)d_in[5]; p.lq2 = (const float*)d_in[6];
  p.lk2 = (const float*)d_in[7]; p.subln = (const float*)d_in[8]; p.gn_g = (const float*)d_in[9]; p.gn_b = (const float*)d_in[10];
  p.A_re = (const float*)d_in[11]; p.A_im = (const float*)d_in[12]; p.log_dt = (const float*)d_in[13]; p.B_re = (const float*)d_in[14];
  p.B_im = (const float*)d_in[15]; p.C_re = (const float*)d_in[16]; p.C_im = (const float*)d_in[17]; p.Dp = (const float*)d_in[18];
  p.glu_w = (const float*)d_in[19]; p.glu_b = (const float*)d_in[20]; p.w_out = (const float*)d_in[21]; p.ln1g = (const float*)d_in[22];
  p.ln1b = (const float*)d_in[23]; p.w_up = (const float*)d_in[24]; p.conv_w = (const float*)d_in[25]; p.conv_b = (const float*)d_in[26];
  p.w_down = (const float*)d_in[27]; p.ple_w = (const float*)d_in[28]; p.gate_w = (const float*)d_in[29]; p.ln2g = (const float*)d_in[30];
  p.ln2b = (const float*)d_in[31];
  p.out = (float*)d_out; p.ws = (char*)d_ws;
#if MK_LAUNCHES == 1
  int ph0 = 0, ph1 = NPH;
  void* args[] = {&p, &ph0, &ph1};
  (void)hipMemsetAsync((char*)d_ws + OFF_BAR, 0, SZ_BAR, stream);
  hipError_t e = hipLaunchCooperativeKernel((void*)mega, dim3(grid_blocks), dim3(NTHR), args, LDS_TOTAL, stream);
  if (e != hipSuccess) fprintf(stderr, "cooperative launch failed: %s (grid %d)\n", hipGetErrorString(e), grid_blocks);
#else
  for (int ph = 0; ph < NPH; ++ph) hipLaunchKernelGGL(mega, dim3(grid_blocks), dim3(NTHR), LDS_TOTAL, stream, p, ph, ph + 1);
#endif
}
```

```cpp
#include <hip/hip_runtime.h>
#include <hip/hip_cooperative_groups.h>
#include <cstdio>
#include <cstdint>
namespace cg = cooperative_groups;

typedef unsigned short u16;
using bf16x8 = __attribute__((ext_vector_type(8))) short;
using s16x4  = __attribute__((ext_vector_type(4))) short;
using f32x16 = __attribute__((ext_vector_type(16))) float;
using u32x4  = __attribute__((ext_vector_type(4))) unsigned;
using u32x2  = __attribute__((ext_vector_type(2))) unsigned;

#ifndef PROBE_MASK
#define PROBE_MASK 0
#endif
#ifndef PROBE_SYNCS
#define PROBE_SYNCS 0
#endif
#ifndef MK_LAUNCHES
#define MK_LAUNCHES 1
#endif

constexpr int TT = 32768, SEQ = 8192, DM = 1024, ZC = 2816, DFF = 2816;
constexpr int C_DAK = 512, C_DAV = 1024, C_RQ = 1536, C_RK = 1792, C_RV = 2048, C_RG = 2304, C_U = 2560;
constexpr float ALPHA = 1.4142135623730951f;
constexpr int NTHR = 256;
constexpr int LDS_BYTES = 74752, LDS_TOTAL = LDS_BYTES + 16;

constexpr size_t al256(size_t x) { return (x + 255) / 256 * 256; }
constexpr size_t SZ_WIN = (size_t)2816 * 1024 * 2, SZ_WOUT = (size_t)1024 * 1024 * 2, SZ_WUP = (size_t)5632 * 1024 * 2,
                 SZ_WDN = (size_t)1024 * 2816 * 2, SZ_WPLE = (size_t)1024 * 256 * 2, SZ_WGATE = (size_t)1024 * 1024 * 2,
                 SZ_WGLU = (size_t)256 * 256 * 2;
constexpr size_t SZ_S5M = (size_t)16 * 512 * 768 * 2, SZ_S5F = (size_t)16 * 256 * 512 * 2;
constexpr size_t OFF_WIN = 0;
constexpr size_t OFF_WOUT = OFF_WIN + 2 * SZ_WIN;
constexpr size_t OFF_WUP = OFF_WOUT + 2 * SZ_WOUT;
constexpr size_t OFF_WDN = OFF_WUP + 2 * SZ_WUP;
constexpr size_t OFF_WPLE = OFF_WDN + 2 * SZ_WDN;
constexpr size_t OFF_WGATE = OFF_WPLE + 2 * SZ_WPLE;
constexpr size_t OFF_WGLU = OFF_WGATE + 2 * SZ_WGATE;
constexpr size_t OFF_S5M = OFF_WGLU + 2 * SZ_WGLU;
constexpr size_t OFF_S5F = OFF_S5M + 2 * SZ_S5M;
constexpr size_t OFF_PW = OFF_S5F + 2 * SZ_S5F;
constexpr size_t SZ_PW = (size_t)2 * 2 * 16 * 64 * 33 * 2 * 4;
constexpr size_t OFF_BB = al256(OFF_PW + SZ_PW);
constexpr size_t SZ_BB = (size_t)2 * 2 * 16 * 64 * 16 * 2 * 4;
constexpr size_t OFF_KTAB = al256(OFF_BB + SZ_BB);
constexpr size_t SZ_KTAB = (size_t)2 * 16 * 2 * 32 * 256 * 4;
constexpr size_t OFF_LAM = al256(OFF_KTAB + SZ_KTAB);
constexpr size_t OFF_BAR = OFF_LAM + 256;
constexpr size_t SZ_BAR = 3456 * 4;
constexpr size_t OFF_ZERO = OFF_BAR + SZ_BAR;
constexpr size_t OFF_KMX = OFF_ZERO + 2048;
constexpr size_t OFF_COS = OFF_KMX + 16384;
constexpr size_t OFF_SIN = OFF_COS + (size_t)TT * 32 * 4;
constexpr size_t OFF_XB = OFF_SIN + (size_t)TT * 32 * 4;
constexpr size_t OFF_R1 = OFF_XB + (size_t)TT * 1024 * 2;
constexpr size_t OFF_Z = OFF_R1;
constexpr size_t OFF_YMIX = OFF_Z + (size_t)TT * ZC * 2;
constexpr size_t OFF_YGB = OFF_YMIX + (size_t)TT * 1024 * 2;
constexpr size_t OFF_XEND = OFF_YGB + (size_t)TT * 256 * 2;
constexpr size_t OFF_SINS = OFF_XEND + (size_t)1024 * 16 * 256 * 4;
constexpr size_t OFF_KVT = OFF_SINS + (size_t)1024 * 16 * 256 * 2;
constexpr size_t OFF_KVS = OFF_KVT + (size_t)16 * 64 * 2 * 4096 * 4;
constexpr size_t OFF_R1END = OFF_KVS + (size_t)16 * 64 * 2 * 4096 * 2;
constexpr size_t OFF_PB = OFF_YGB;
constexpr size_t OFF_HALO = OFF_YMIX;
constexpr size_t OFF_PRE1 = OFF_Z;
constexpr size_t OFF_PRE2 = OFF_YMIX;
constexpr size_t OFF_A = OFF_R1;
constexpr size_t WS_NEED = OFF_R1END;

struct P {
  const float *x, *p; const int* pos;
  const float *w_in, *lq1, *lk1, *lq2, *lk2, *subln, *gn_g, *gn_b, *A_re, *A_im, *log_dt, *B_re, *B_im, *C_re, *C_im, *Dp,
      *glu_w, *glu_b, *w_out, *ln1g, *ln1b, *w_up, *conv_w, *conv_b, *w_down, *ple_w, *gate_w, *ln2g, *ln2b;
  float* out; char* ws;
};

__device__ __forceinline__ unsigned cvtpk(float lo, float hi) {
  unsigned r; asm volatile("v_cvt_pk_bf16_f32 %0, %1, %2" : "=v"(r) : "v"(lo), "v"(hi)); return r;
}
__device__ __forceinline__ u16 f2bf(float x) { return (u16)(cvtpk(x, 0.f) & 0xffffu); }
__device__ __forceinline__ float bf2f(u16 v) { return __uint_as_float(((unsigned)v) << 16); }
__device__ __forceinline__ float4 ntld4(const void* q) {
  typedef float f4_ __attribute__((ext_vector_type(4)));
  const f4_ t = __builtin_nontemporal_load((const f4_*)q); return float4{t[0], t[1], t[2], t[3]};
}
__device__ __forceinline__ int crow(int r, int hi) { return (r & 3) + 8 * (r >> 2) + 4 * hi; }
__device__ __forceinline__ float gelu_t(float x) {
  constexpr float c1 = -2.f * 1.4426950408889634f * 0.7978845608028654f, c2 = c1 * 0.044715f;
  const float t = x * fmaf(c2, x * x, c1);
  return x * __builtin_amdgcn_rcpf(1.f + __builtin_amdgcn_exp2f(t));
}
__device__ __forceinline__ float sigmoidf_(float x) { return __builtin_amdgcn_rcpf(1.f + __expf(-x)); }
__device__ __forceinline__ float half_sum32(float v) {
  v += __shfl_xor(v, 16); v += __shfl_xor(v, 8); v += __shfl_xor(v, 4); v += __shfl_xor(v, 2); v += __shfl_xor(v, 1); return v;
}
__device__ __forceinline__ float wave_sum(float v) { v += __shfl_xor(v, 32); return half_sum32(v); }
__device__ __forceinline__ int ltid() { int t = (int)threadIdx.x; asm volatile("" : "+v"(t)); return t; }
__device__ __forceinline__ int opq() { int z = 0; asm volatile("" : "+v"(z)); return z; }
#define SBAR() __builtin_amdgcn_sched_barrier(0)
#define MFMA(a, b, c) __builtin_amdgcn_mfma_f32_32x32x16_bf16(a, b, c, 0, 0, 0)

struct LdBf { const u16* base; long ld;
  __device__ __forceinline__ const u16* ptr(int row, int k) const { return base + (long)row * ld + k; } };
struct LdS5 { const u16* z; const u16* sins; int g; int chunk0;
  __device__ __forceinline__ const u16* ptr(int row, int k) const {
    const long chunk = chunk0 + row;
    return (k < 512) ? z + (chunk * 32 + (k >> 4)) * ZC + C_U + g * 16 + (k & 15) : sins + (chunk * 16 + g) * 256 + (k - 512); } };
struct LdBsplit { const u16* base; long ld; int f0;
  __device__ __forceinline__ const u16* ptr(int row, int k) const {
    const int rr = (row < 64) ? f0 + row : DFF + f0 + row - 64; return base + (long)rr * ld + k; } };
__device__ __forceinline__ void glds16(const void* g, void* l) {
  __builtin_amdgcn_global_load_lds((const __attribute__((address_space(1))) unsigned*)g, (__attribute__((address_space(3))) unsigned*)l, 16, 0, 0);
}

template <bool HALO, class AL, class BL>
__device__ __forceinline__ void gemm_core(f32x16 (&acc)[2][2], f32x16& hacc, const AL& al, const BL& bl, int K, char* lds,
                                          const u16* halo0, const u16* halo1, int brow0, int brow1) {
  constexpr int ABYTES = HALO ? 136 * 128 : 128 * 128, BUF = ABYTES + 16384;
  const int tid = ltid(), lane = tid & 63, wid = tid >> 6, wr = wid >> 1, r32 = lane & 31, hi = lane >> 5;
  const int lrow = tid >> 3, cg = ((tid & 7) ^ ((lrow >> 1) & 7)) * 8;
  const u16* gh = nullptr;
  if (HALO) { const int c = ((lane & 7) ^ ((lane >> 4) & 7)) * 8; gh = ((lane < 8) ? halo0 : halo1) + c; }
  char* lw = lds + tid * 16;
#define ISSUE(k0, bf) do { char* A_ = lw + (bf) * BUF; \
    _Pragma("unroll") for (int i_ = 0; i_ < 4; ++i_) { glds16(al.ptr(lrow + 32 * i_, (k0) + cg), A_ + i_ * 4096); glds16(bl.ptr(lrow + 32 * i_, (k0) + cg), A_ + ABYTES + i_ * 4096); } \
    if (HALO) { if (wid == 0) glds16(gh + (k0), A_ + 16384); } } while (0)
  const int sa = ((wr * 64 + r32) >> 1) & 7, sb0 = ((brow0 + r32) >> 1) & 7, sb1 = ((brow1 + r32) >> 1) & 7, sh = (r32 >> 1) & 7;
  const int oa = (wr * 64 + r32) * 128, ob0 = ABYTES + (brow0 + r32) * 128, ob1 = ABYTES + (brow1 + r32) * 128, oh = (128 + r32) * 128;
  __syncthreads();
  ISSUE(0, 0);
  const int nk = K >> 6;
  for (int kt = 0; kt < nk; ++kt) {
    asm volatile("s_waitcnt vmcnt(0)" ::: "memory");
    __syncthreads();
    if (kt + 1 < nk) ISSUE((kt + 1) * 64, (kt + 1) & 1);
    const char* T = lds + (kt & 1) * BUF;
#pragma unroll
    for (int kk = 0; kk < 4; ++kk) {
      const int c = kk * 2 + hi;
      bf16x8 a0 = *(const bf16x8*)(T + oa + ((c ^ sa) << 4));
      bf16x8 a1 = *(const bf16x8*)(T + oa + 4096 + ((c ^ sa) << 4));
      bf16x8 b0 = *(const bf16x8*)(T + ob0 + ((c ^ sb0) << 4));
      bf16x8 b1 = *(const bf16x8*)(T + ob1 + ((c ^ sb1) << 4));
      acc[0][0] = MFMA(a0, b0, acc[0][0]); acc[0][1] = MFMA(a0, b1, acc[0][1]);
      acc[1][0] = MFMA(a1, b0, acc[1][0]); acc[1][1] = MFMA(a1, b1, acc[1][1]);
      if (HALO) { bf16x8 ah = *(const bf16x8*)(T + oh + ((c ^ sh) << 4)); hacc = MFMA(ah, b0, hacc); }
    }
  }
#undef ISSUE
}
template <class AL, class BL>
__device__ __forceinline__ void gemm_plain(f32x16 (&acc)[2][2], const AL& al, const BL& bl, int K, char* lds) {
  f32x16 dummy = {};
  const int wc = (ltid() >> 6) & 1;
  gemm_core<false>(acc, dummy, al, bl, K, lds, nullptr, nullptr, wc * 64, wc * 64 + 32);
}
__device__ __forceinline__ bool tile_at(int it, int nM, int nN, int& tm, int& tn) {
  const int total = nM * nN, per = (total + 7) / 8, x = blockIdx.x & 7, lb = blockIdx.x >> 3, nlb = gridDim.x >> 3;
  const int i = lb + it * nlb; if (i >= per) return false;
  const int idx = x * per + i; if (idx >= total) return false;
  const int grp = idx / (8 * nN), rem = idx - grp * 8 * nN;
  tm = grp * 8 + (rem & 7); tn = rem >> 3; return true;
}

__device__ __forceinline__ void transpose_tile(const float* src, u16* dst, int K, int N, int kt, int nt, char* lds) {
  float* tile = (float*)lds;
  const int tid = ltid();
  __syncthreads();
#pragma unroll
  for (int i = 0; i < 4; ++i) {
    const int e = tid + 256 * i, r = e >> 4, c4 = (e & 15) * 4;
    const float4 v = ntld4(src + (long)(kt * 64 + r) * N + nt * 64 + c4);
    tile[r * 65 + c4] = v.x; tile[r * 65 + c4 + 1] = v.y; tile[r * 65 + c4 + 2] = v.z; tile[r * 65 + c4 + 3] = v.w;
  }
  __syncthreads();
#pragma unroll
  for (int i = 0; i < 2; ++i) {
    const int e = tid + 256 * i, n = e >> 3, k8 = (e & 7) * 8;
    u32x4 w;
    w.x = cvtpk(tile[(k8 + 0) * 65 + n], tile[(k8 + 1) * 65 + n]); w.y = cvtpk(tile[(k8 + 2) * 65 + n], tile[(k8 + 3) * 65 + n]);
    w.z = cvtpk(tile[(k8 + 4) * 65 + n], tile[(k8 + 5) * 65 + n]); w.w = cvtpk(tile[(k8 + 6) * 65 + n], tile[(k8 + 7) * 65 + n]);
    *(u32x4*)(dst + (long)(nt * 64 + n) * K + kt * 64 + k8) = w;
  }
}
__device__ __forceinline__ void phase0(const P& p, char* lds) {
  const int tid = ltid(), bid = blockIdx.x, nb = gridDim.x;
  for (int layer = 0; layer < 2; ++layer) {
    for (int m = 0; m < 7; ++m) {
      const float* src; u16* dst; int K, N;
      switch (m) {
        case 0: src = p.w_in + (size_t)layer * 1024 * 2816; dst = (u16*)(p.ws + OFF_WIN + layer * SZ_WIN); K = 1024; N = 2816; break;
        case 1: src = p.w_out + (size_t)layer * 1024 * 1024; dst = (u16*)(p.ws + OFF_WOUT + layer * SZ_WOUT); K = 1024; N = 1024; break;
        case 2: src = p.w_up + (size_t)layer * 1024 * 5632; dst = (u16*)(p.ws + OFF_WUP + layer * SZ_WUP); K = 1024; N = 5632; break;
        case 3: src = p.w_down + (size_t)layer * 2816 * 1024; dst = (u16*)(p.ws + OFF_WDN + layer * SZ_WDN); K = 2816; N = 1024; break;
        case 4: src = p.ple_w + (size_t)layer * 256 * 1024; dst = (u16*)(p.ws + OFF_WPLE + layer * SZ_WPLE); K = 256; N = 1024; break;
        case 5: src = p.gate_w + (size_t)layer * 1024 * 1024; dst = (u16*)(p.ws + OFF_WGATE + layer * SZ_WGATE); K = 1024; N = 1024; break;
        default: src = p.glu_w + (size_t)layer * 256 * 256; dst = (u16*)(p.ws + OFF_WGLU + layer * SZ_WGLU); K = 256; N = 256; break;
      }
      const int nkt = K / 64, nnt = N / 64;
      for (int t = bid; t < nkt * nnt; t += nb) transpose_tile(src, dst, K, N, t / nnt, t % nnt, lds);
    }
  }
  const long gt = (long)bid * NTHR + tid, gn = (long)nb * NTHR;
  { u16* xb = (u16*)(p.ws + OFF_XB);
    for (long i = gt; i < (long)TT * DM / 8; i += gn) {
      const float4* q = (const float4*)(p.x + i * 8); float4 a = ntld4(q), b = ntld4(q + 1);
      u32x4 w = {cvtpk(a.x, a.y), cvtpk(a.z, a.w), cvtpk(b.x, b.y), cvtpk(b.z, b.w)};
      *(u32x4*)(xb + i * 8) = w; } }
  { float* ct = (float*)(p.ws + OFF_COS); float* st = (float*)(p.ws + OFF_SIN);
    for (long i = gt; i < (long)TT * 32; i += gn) {
      const int t = (int)(i >> 5), j = (int)(i & 31);
      const float inv = powf(10000.f, -(float)(2 * j) / 64.f);
      const float ang = (float)p.pos[t] * inv;
      float s, c; sincosf(ang, &s, &c); ct[i] = c; st[i] = s; } }
  { float* pw = (float*)(p.ws + OFF_PW); float* bb = (float*)(p.ws + OFF_BB);
    for (long t = gt; t < (long)4096 * 33; t += gn) {
      const long i = t / 33; const int k = (int)(t - i * 33);
      const double are = p.A_re[i], aim = p.A_im[i], step = exp((double)p.log_dt[i >> 6]);
      const double mag = exp(k * step * are), ang = k * step * aim;
      pw[t * 2] = (float)(mag * cos(ang)); pw[t * 2 + 1] = (float)(mag * sin(ang));
    }
    for (long t = gt; t < (long)4096 * 16; t += gn) {
      const long i = t >> 4;
      const double are = p.A_re[i], aim = p.A_im[i], step = exp((double)p.log_dt[i >> 6]);
      const double e = exp(step * are), abr = e * cos(step * aim), abi = e * sin(step * aim);
      const double den = are * are + aim * aim, nr = abr - 1.0, ni = abi;
      const double cre = (nr * are + ni * aim) / den, cim = (ni * are - nr * aim) / den;
      const double br = p.B_re[t], bi = p.B_im[t];
      bb[t * 2] = (float)(cre * br - cim * bi); bb[t * 2 + 1] = (float)(cre * bi + cim * br);
    } }
  if (gt < 512) ((unsigned*)(p.ws + OFF_ZERO))[gt] = 0u;
  if (gt < 2) {
    const int l = (int)gt; float s1 = 0.f, s2 = 0.f;
    for (int j = 0; j < 64; ++j) { s1 += p.lq1[l * 64 + j] * p.lk1[l * 64 + j]; s2 += p.lq2[l * 64 + j] * p.lk2[l * 64 + j]; }
    const float linit = 0.8f - 0.6f * expf(-0.3f * (float)l);
    ((float*)(p.ws + OFF_LAM))[l] = expf(s1) - expf(s2) + linit;
    ((float*)(p.ws + OFF_LAM))[2 + l] = 1.f - linit;
  }
}

__device__ __forceinline__ void s5_build_ktab_F(const P& p) {
  const unsigned gt = blockIdx.x * NTHR + ltid(), gn = gridDim.x * NTHR;
  const float* pw = (const float*)(p.ws + OFF_PW); const float* bb = (const float*)(p.ws + OFF_BB);
  float* kt = (float*)(p.ws + OFF_KTAB);
  for (unsigned i = gt; i < 2u * 16 * 2 * 32 * 256; i += gn) {
    const int ci = (int)(i & 15), co = (int)((i >> 4) & 15), lag = (int)((i >> 8) & 31), dir = (int)((i >> 13) & 1), g = (int)((i >> 14) & 15), l = (int)(i >> 18);
    const long ldg = ((long)(l * 2 + dir) * 16 + g);
    const float* cre = p.C_re + (ldg * 16 + co) * 64; const float* cim = p.C_im + (ldg * 16 + co) * 64;
    float s = 0.f;
    for (int q = 0; q < 64; ++q) {
      const long lp = ldg * 64 + q;
      const float pr = pw[(lp * 33 + lag) * 2], pi = pw[(lp * 33 + lag) * 2 + 1];
      const float br = bb[(lp * 16 + ci) * 2], bi = bb[(lp * 16 + ci) * 2 + 1];
      const float wre = pr * br - pi * bi, wim = pr * bi + pi * br;
      s += cre[q] * wre - cim[q] * wim;
    }
    kt[i] = s;
  }
  for (unsigned i = gt; i < 2u * 16 * 256 * 512; i += gn) {
    const int kk = (int)(i & 511), n = (int)((i >> 9) & 255), g = (int)((i >> 17) & 15), l = (int)(i >> 21);
    const int dir = n >> 7, isim = (n >> 6) & 1, q = n & 63, j = kk >> 4, ci = kk & 15;
    const long lp = (((long)(l * 2 + dir) * 16 + g) * 64 + q);
    const int pwk = dir ? j : 31 - j;
    const float pr = pw[(lp * 33 + pwk) * 2], pi = pw[(lp * 33 + pwk) * 2 + 1];
    const float br = bb[(lp * 16 + ci) * 2], bi = bb[(lp * 16 + ci) * 2 + 1];
    const float v = isim ? (pr * bi + pi * br) : (pr * br - pi * bi);
    ((u16*)(p.ws + OFF_S5F))[i] = f2bf(v);
  }
}
__device__ __forceinline__ void s5_build_M(const P& p) {
  const unsigned gt = blockIdx.x * NTHR + ltid(), gn = gridDim.x * NTHR;
  const float* pw = (const float*)(p.ws + OFF_PW); const float* kt = (const float*)(p.ws + OFF_KTAB);
  for (unsigned i = gt; i < 2u * 16 * 512 * 768; i += gn) {
    const unsigned r = i / 768u; const int kk = (int)(i - r * 768u); const int n = (int)(r & 511), g = (int)((r >> 9) & 15), l = (int)(r >> 13);
    const int ii = n >> 4, co = n & 15;
    float v;
    if (kk < 512) {
      const int j = kk >> 4, ci = kk & 15;
      const float* k0 = kt + ((long)(l * 16 + g) * 2 + 0) * 32 * 256; const float* k1 = k0 + 32 * 256;
      if (ii > j) v = k0[(ii - j) * 256 + co * 16 + ci];
      else if (ii < j) v = k1[(j - ii) * 256 + co * 16 + ci];
      else v = k0[co * 16 + ci] + k1[co * 16 + ci] + (co == ci ? p.Dp[l * 256 + g * 16 + co] : 0.f);
    } else {
      const int qq = kk - 512, dir = qq >> 7, isim = (qq >> 6) & 1, q = qq & 63;
      const long ldg = ((long)(l * 2 + dir) * 16 + g);
      const int pwk = dir ? 32 - ii : ii + 1;
      const float pr = pw[((ldg * 64 + q) * 33 + pwk) * 2], pi = pw[((ldg * 64 + q) * 33 + pwk) * 2 + 1];
      const float cr = p.C_re[(ldg * 16 + co) * 64 + q], cim = p.C_im[(ldg * 16 + co) * 64 + q];
      v = isim ? -(cr * pi + cim * pr) : (cr * pr - cim * pi);
    }
    ((u16*)(p.ws + OFF_S5M))[i] = f2bf(v);
  }
}

__device__ __forceinline__ void phase_z(const P& p, int layer, char* lds) {
  const u16* xb = (const u16*)(p.ws + OFF_XB); const u16* wt = (const u16*)(p.ws + OFF_WIN + layer * SZ_WIN);
  u16* z = (u16*)(p.ws + OFF_Z);
  const float* ct = (const float*)(p.ws + OFF_COS); const float* st = (const float*)(p.ws + OFF_SIN);
  const int lane = ltid() & 63, wid = ltid() >> 6, wr = wid >> 1, wc = wid & 1, r32 = lane & 31, hi = lane >> 5;
  int tm, tn;
  for (int it = 0; tile_at(it, 256, 22, tm, tn); ++it) {
    f32x16 acc[2][2] = {};
    LdBf al{xb + (long)tm * 128 * DM, DM}, bl{wt + (long)tn * 128 * DM, DM};
    gemm_plain(acc, al, bl, DM, lds);
    const int span = tn * 2 + wc, colb = span * 64;
    const bool rope = (span < 16) || (span >= 24 && span < 32);
    const float sc = (span < 8 || (span >= 28 && span < 32)) ? 0.125f : 1.f;
    const unsigned rb = (unsigned)(tm * 128 + wr * 64 + 4 * hi + opq());
    if (rope) {
#pragma unroll
      for (int mi = 0; mi < 2; ++mi) {
        float cc[16], ss[16];
#pragma unroll
        for (int r = 0; r < 16; ++r) { const unsigned row = rb + mi * 32 + (r & 3) + 8 * (r >> 2); cc[r] = ct[row * 32 + r32]; ss[r] = st[row * 32 + r32]; }
#pragma unroll
        for (int r = 0; r < 16; ++r) {
          const unsigned row = rb + mi * 32 + (r & 3) + 8 * (r >> 2);
          const float x1 = acc[mi][0][r], x2 = acc[mi][1][r];
          const unsigned w = cvtpk((x1 * cc[r] - x2 * ss[r]) * sc, (x2 * cc[r] + x1 * ss[r]) * sc);
          z[row * ZC + colb + r32] = (u16)w; z[row * ZC + colb + 32 + r32] = (u16)(w >> 16);
        }
        SBAR();
      }
    } else {
#pragma unroll
      for (int mi = 0; mi < 2; ++mi) {
#pragma unroll
        for (int r = 0; r < 16; ++r) {
          const unsigned row = rb + mi * 32 + (r & 3) + 8 * (r >> 2);
          const unsigned w = cvtpk(acc[mi][0][r] * sc, acc[mi][1][r] * sc);
          z[row * ZC + colb + r32] = (u16)w; z[row * ZC + colb + 32 + r32] = (u16)(w >> 16);
        }
        SBAR();
      }
    }
  }
}

__device__ __forceinline__ float ret_log2gamma(int h) { return log2f(1.f - exp2f(-5.f - (float)h)); }
__device__ __forceinline__ void ret_kv_item(const P& p, int item, char* lds) {
  const int tid = ltid(), lane = tid & 63, wid = tid >> 6, r32 = lane & 31, hi = lane >> 5;
  const int c = item & 63, h = (item >> 6) & 3, b = item >> 8;
  const u16* z = (const u16*)(p.ws + OFF_Z);
  const long tok0 = (long)b * SEQ + c * 128;
  u16* VT = (u16*)lds; u16* KF = VT + 64 * 136; u16* KB = KF + 64 * 136;
  const float lg = ret_log2gamma(h);
  { const int j = tid & 127, m = tid >> 7;
    const u16* kp = z + (tok0 + j) * ZC + C_DAK + h * 128 + m * 64;
    float ss = 0.f;
#pragma unroll
    for (int q8 = 0; q8 < 8; ++q8) { const bf16x8 kv = *(const bf16x8*)(kp + q8 * 8);
#pragma unroll
      for (int q = 0; q < 8; ++q) { const float f = bf2f((u16)kv[q]); ss += f * f; } }
#pragma unroll
    for (int o = 32; o >= 1; o >>= 1) ss = fmaxf(ss, __shfl_xor(ss, o));
    if (lane == 0) ((float*)(p.ws + OFF_KMX))[(((b * 4 + h) * 2 + m) * 64 + c) * 2 + (wid & 1)] = ss; }
  __syncthreads();
  for (int e = tid; e < 128 * 8; e += NTHR) {
    const int j = e >> 3, c8 = (e & 7) * 8;
    const bf16x8 kv = *(const bf16x8*)(z + (tok0 + j) * ZC + C_RK + h * 64 + c8);
    const bf16x8 vv = *(const bf16x8*)(z + (tok0 + j) * ZC + C_RV + h * 64 + c8);
    const float df = exp2f(lg * (float)(127 - j)), db = exp2f(lg * (float)j);
#pragma unroll
    for (int q = 0; q < 8; ++q) {
      const float kf = bf2f((u16)kv[q]);
      KF[(c8 + q) * 136 + j] = f2bf(kf * df); KB[(c8 + q) * 136 + j] = f2bf(kf * db); VT[(c8 + q) * 136 + j] = (u16)vv[q];
    }
  }
  __syncthreads();
  const int dir = wid >> 1, vb = wid & 1;
  const u16* KT = dir ? KB : KF;
  f32x16 a0 = {}, a1 = {};
#pragma unroll
  for (int ks = 0; ks < 8; ++ks) {
    const int ko = ks * 16 + hi * 8;
    const bf16x8 av = *(const bf16x8*)&VT[(vb * 32 + r32) * 136 + ko];
    const bf16x8 b0 = *(const bf16x8*)&KT[(r32) * 136 + ko];
    const bf16x8 b1 = *(const bf16x8*)&KT[(32 + r32) * 136 + ko];
    a0 = MFMA(av, b0, a0); a1 = MFMA(av, b1, a1);
  }
  float* kvt = (float*)(p.ws + OFF_KVT) + ((long)((b * 4 + h) * 64 + c) * 2 + dir) * 4096;
#pragma unroll
  for (int r = 0; r < 16; ++r) { const int v = vb * 32 + crow(r, hi); kvt[v * 64 + r32] = a0[r]; kvt[v * 64 + 32 + r32] = a1[r]; }
}
__device__ __forceinline__ void ret_scan(const P& p) {
  const long gt = (long)blockIdx.x * NTHR + ltid(), gn = (long)gridDim.x * NTHR;
  const float* kvt = (const float*)(p.ws + OFF_KVT); u16* kvs = (u16*)(p.ws + OFF_KVS);
  for (long i = gt; i < 16 * 2 * 4096; i += gn) {
    const int e = (int)(i & 4095), dir = (int)((i >> 12) & 1), bh = (int)(i >> 13), h = bh & 3;
    const float cd = exp2f(ret_log2gamma(h) * 128.f);
    float s = 0.f;
    const long base = ((long)(bh * 64) * 2 + dir) * 4096 + e;
    float v[64];
#pragma unroll
    for (int cc = 0; cc < 64; ++cc) v[cc] = kvt[base + (long)(dir ? 63 - cc : cc) * 8192];
#pragma unroll
    for (int cc = 0; cc < 64; ++cc) { kvs[base + (long)(dir ? 63 - cc : cc) * 8192] = f2bf(s); s = cd * s + v[cc]; }
  }
}
__device__ __forceinline__ void ret_out_item(const P& p, int layer, int item, char* lds) {
  const int tid = ltid(), lane = tid & 63, wid = tid >> 6, r32 = lane & 31, hi = lane >> 5;
  const int c = item & 63, h = (item >> 6) & 3, b = item >> 8;
  const u16* z = (const u16*)(p.ws + OFF_Z);
  const long tok0 = (long)b * SEQ + c * 128;
  u16* Qs = (u16*)lds; u16* Ks = Qs + 128 * 72; u16* VT = Ks + 128 * 72; u16* SF = VT + 64 * 136; u16* SB = SF + 64 * 72;
  const float lg = ret_log2gamma(h);
  __syncthreads();
  for (int e = tid; e < 128 * 8; e += NTHR) {
    const int j = e >> 3, c8 = (e & 7) * 8;
    *(bf16x8*)&Qs[j * 72 + c8] = *(const bf16x8*)(z + (tok0 + j) * ZC + C_RQ + h * 64 + c8);
    *(bf16x8*)&Ks[j * 72 + c8] = *(const bf16x8*)(z + (tok0 + j) * ZC + C_RK + h * 64 + c8);
    const bf16x8 vv = *(const bf16x8*)(z + (tok0 + j) * ZC + C_RV + h * 64 + c8);
#pragma unroll
    for (int q = 0; q < 8; ++q) VT[(c8 + q) * 136 + j] = (u16)vv[q];
  }
  { const u16* kvs = (const u16*)(p.ws + OFF_KVS) + ((long)((b * 4 + h) * 64 + c) * 2) * 4096;
    for (int e = tid; e < 2 * 64 * 8; e += NTHR) {
      const int dir = e >> 9, v = (e >> 3) & 63, c8 = (e & 7) * 8;
      *(bf16x8*)&((dir ? SB : SF)[v * 72 + c8]) = *(const bf16x8*)(kvs + (long)dir * 4096 + v * 64 + c8);
    } }
  __syncthreads();
  const int il = wid * 32 + r32;
  bf16x8 qf[4];
#pragma unroll
  for (int d0 = 0; d0 < 4; ++d0) qf[d0] = *(const bf16x8*)&Qs[il * 72 + d0 * 16 + hi * 8];
  bf16x8 pa[8];
#pragma unroll
  for (int jb = 0; jb < 4; ++jb) {
    f32x16 s = {};
#pragma unroll
    for (int d0 = 0; d0 < 4; ++d0) { const bf16x8 kf = *(const bf16x8*)&Ks[(jb * 32 + r32) * 72 + d0 * 16 + hi * 8]; s = MFMA(kf, qf[d0], s); }
#pragma unroll
    for (int r = 0; r < 16; ++r) { const int j = jb * 32 + crow(r, hi); const int dd = il > j ? il - j : j - il; s[r] *= exp2f(lg * (float)dd); }
#define PK4(PV, BASE, OUT) do { unsigned a0_ = cvtpk(PV[BASE + 0], PV[BASE + 1]), a1_ = cvtpk(PV[BASE + 2], PV[BASE + 3]);   \
    unsigned b0_ = cvtpk(PV[BASE + 4], PV[BASE + 5]), b1_ = cvtpk(PV[BASE + 6], PV[BASE + 7]);                              \
    auto r0_ = __builtin_amdgcn_permlane32_swap(a0_, b0_, false, false); auto r1_ = __builtin_amdgcn_permlane32_swap(a1_, b1_, false, false); \
    u32x4 w_ = {r0_[0], r1_[0], r0_[1], r1_[1]}; OUT = *reinterpret_cast<bf16x8*>(&w_); } while (0)
    PK4(s, 0, pa[2 * jb]); PK4(s, 8, pa[2 * jb + 1]);
  }
  f32x16 in0 = {}, in1 = {}, cf0 = {}, cf1 = {}, cb0 = {}, cb1 = {};
#pragma unroll
  for (int ks = 0; ks < 8; ++ks) {
    const bf16x8 v0 = *(const bf16x8*)&VT[(r32) * 136 + ks * 16 + hi * 8];
    const bf16x8 v1 = *(const bf16x8*)&VT[(32 + r32) * 136 + ks * 16 + hi * 8];
    in0 = MFMA(pa[ks], v0, in0); in1 = MFMA(pa[ks], v1, in1);
  }
#pragma unroll
  for (int d0 = 0; d0 < 4; ++d0) {
    const int ko = d0 * 16 + hi * 8;
    const bf16x8 f0 = *(const bf16x8*)&SF[(r32) * 72 + ko], f1 = *(const bf16x8*)&SF[(32 + r32) * 72 + ko];
    const bf16x8 g0 = *(const bf16x8*)&SB[(r32) * 72 + ko], g1 = *(const bf16x8*)&SB[(32 + r32) * 72 + ko];
    cf0 = MFMA(qf[d0], f0, cf0); cf1 = MFMA(qf[d0], f1, cf1); cb0 = MFMA(qf[d0], g0, cb0); cb1 = MFMA(qf[d0], g1, cb1);
  }
  const float gg0 = p.gn_g[layer * 64 + r32], gg1 = p.gn_g[layer * 64 + 32 + r32], gb0 = p.gn_b[layer * 64 + r32], gb1 = p.gn_b[layer * 64 + 32 + r32];
  u16* ymix = (u16*)(p.ws + OFF_YMIX);
  const int ib = wid * 32 + 4 * hi + opq();
  u16 gv0[16], gv1[16];
#pragma unroll
  for (int r = 0; r < 16; ++r) { const unsigned row = (unsigned)tok0 + ib + (r & 3) + 8 * (r >> 2);
    gv0[r] = z[row * ZC + C_RG + h * 64 + r32]; gv1[r] = z[row * ZC + C_RG + h * 64 + 32 + r32]; }
#pragma unroll
  for (int r = 0; r < 16; ++r) {
    const int i = ib + (r & 3) + 8 * (r >> 2);
    const float qd_f = exp2f(lg * (float)(i + 1)), qd_b = exp2f(lg * (float)(128 - i));
    const float o0 = in0[r] + qd_f * cf0[r] + qd_b * cb0[r], o1 = in1[r] + qd_f * cf1[r] + qd_b * cb1[r];
    const float mu = half_sum32(o0 + o1) * (1.f / 64.f);
    const float e0 = o0 - mu, e1 = o1 - mu;
    const float var = half_sum32(e0 * e0 + e1 * e1) * (1.f / 64.f);
    const float rs = rsqrtf(var + 1e-5f);
    const unsigned row = (unsigned)tok0 + i;
    const float g0 = bf2f(gv0[r]), g1 = bf2f(gv1[r]);
    ymix[row * 1024 + 512 + h * 64 + r32] = f2bf(g0 * sigmoidf_(g0) * (e0 * rs * gg0 + gb0));
    ymix[row * 1024 + 512 + h * 64 + 32 + r32] = f2bf(g1 * sigmoidf_(g1) * (e1 * rs * gg1 + gb1));
  }
}

__device__ __forceinline__ void s5_state_tile(const P& p, int layer, int t, char* lds) {
  const int g = t >> 4, tm = (t >> 1) & 7, tn = t & 1;
  const int lane = ltid() & 63, wid = ltid() >> 6, wr = wid >> 1, wc = wid & 1, r32 = lane & 31, hi = lane >> 5;
  f32x16 acc[2][2] = {};
  LdS5 al{(const u16*)(p.ws + OFF_Z), nullptr, g, tm * 128};
  LdBf bl{(const u16*)(p.ws + OFF_S5F + layer * SZ_S5F) + ((long)g * 256 + tn * 128) * 512, 512};
  gemm_plain(acc, al, bl, 512, lds);
  float* xe = (float*)(p.ws + OFF_XEND);
  const unsigned cb = (unsigned)(tm * 128 + wr * 64 + 4 * hi + opq());
#pragma unroll
  for (int mi = 0; mi < 2; ++mi) {
#pragma unroll
    for (int ni = 0; ni < 2; ++ni)
#pragma unroll
      for (int r = 0; r < 16; ++r) {
        const unsigned chunk = cb + mi * 32 + (r & 3) + 8 * (r >> 2); const unsigned n = tn * 128 + wc * 64 + ni * 32 + r32;
        xe[(chunk * 16 + g) * 256 + n] = acc[mi][ni][r];
      }
    SBAR();
  }
}
__device__ __forceinline__ void s5_scan(const P& p, int layer) {
  const long gt = (long)blockIdx.x * NTHR + ltid();
  if (gt >= 4 * 16 * 2 * 64) return;
  const int q = (int)(gt & 63), dir = (int)((gt >> 6) & 1), g = (int)((gt >> 7) & 15), b = (int)(gt >> 11);
  const float* pw = (const float*)(p.ws + OFF_PW);
  const long lp = (((long)(layer * 2 + dir) * 16 + g) * 64 + q);
  const float ar = pw[(lp * 33 + 32) * 2], ai = pw[(lp * 33 + 32) * 2 + 1];
  const float* xe = (const float*)(p.ws + OFF_XEND); u16* ss = (u16*)(p.ws + OFF_SINS);
  float sr = 0.f, si = 0.f;
  const long base = ((long)(b * 256) * 16 + g) * 256 + dir * 128 + q;
  for (int c0 = 0; c0 < 256; c0 += 32) {
    float xr[32], xi[32];
#pragma unroll
    for (int k = 0; k < 32; ++k) { const long off = base + (long)(dir ? 255 - (c0 + k) : c0 + k) * 4096; xr[k] = xe[off]; xi[k] = xe[off + 64]; }
#pragma unroll
    for (int k = 0; k < 32; ++k) {
      const long off = base + (long)(dir ? 255 - (c0 + k) : c0 + k) * 4096;
      ss[off] = f2bf(sr); ss[off + 64] = f2bf(si);
      const float nr = ar * sr - ai * si + xr[k], ni = ar * si + ai * sr + xi[k];
      sr = nr; si = ni;
    }
  }
}
__device__ __forceinline__ void s5_out_tile(const P& p, int layer, int t, char* lds) {
  const int g = t >> 5, tm = (t >> 2) & 7, tn = t & 3;
  const int lane = ltid() & 63, wid = ltid() >> 6, wr = wid >> 1, wc = wid & 1, r32 = lane & 31, hi = lane >> 5;
  f32x16 acc[2][2] = {};
  LdS5 al{(const u16*)(p.ws + OFF_Z), (const u16*)(p.ws + OFF_SINS), g, tm * 128};
  LdBf bl{(const u16*)(p.ws + OFF_S5M + layer * SZ_S5M) + ((long)g * 512 + tn * 128) * 768, 768};
  gemm_plain(acc, al, bl, 768, lds);
  u16* yg = (u16*)(p.ws + OFF_YGB);
  const unsigned cb = (unsigned)(tm * 128 + wr * 64 + 4 * hi + opq());
#pragma unroll
  for (int mi = 0; mi < 2; ++mi) {
#pragma unroll
    for (int ni = 0; ni < 2; ++ni)
#pragma unroll
      for (int r = 0; r < 16; ++r) {
        const unsigned chunk = cb + mi * 32 + (r & 3) + 8 * (r >> 2); const unsigned n = tn * 128 + wc * 64 + ni * 32 + r32;
        yg[(chunk * 32 + (n >> 4)) * 256 + g * 16 + (n & 15)] = f2bf(gelu_t(acc[mi][ni][r]));
      }
    SBAR();
  }
}
__device__ __forceinline__ void phase_glu(const P& p, int layer, char* lds) {
  const u16* yg = (const u16*)(p.ws + OFF_YGB); const u16* wt = (const u16*)(p.ws + OFF_WGLU + layer * SZ_WGLU);
  u16* ymix = (u16*)(p.ws + OFF_YMIX);
  const int lane = ltid() & 63, wid = ltid() >> 6, wr = wid >> 1, wc = wid & 1, r32 = lane & 31, hi = lane >> 5;
  int tm, tn;
  for (int it = 0; tile_at(it, 256, 2, tm, tn); ++it) {
    f32x16 acc[2][2] = {};
    LdBf al{yg + (long)tm * 128 * 256, 256}, bl{wt + (long)tn * 128 * 256, 256};
    gemm_plain(acc, al, bl, 256, lds);
    const unsigned rb = (unsigned)(tm * 128 + wr * 64 + 4 * hi + opq());
#pragma unroll
    for (int mi = 0; mi < 2; ++mi) {
#pragma unroll
      for (int ni = 0; ni < 2; ++ni) {
        const unsigned col = tn * 128 + wc * 64 + ni * 32 + r32;
        const float gb = p.glu_b[layer * 256 + col];
        u16 yv[16];
#pragma unroll
        for (int r = 0; r < 16; ++r) yv[r] = yg[(rb + mi * 32 + (r & 3) + 8 * (r >> 2)) * 256 + col];
#pragma unroll
        for (int r = 0; r < 16; ++r) {
          const unsigned row = rb + mi * 32 + (r & 3) + 8 * (r >> 2);
          ymix[row * 1024 + 768 + col] = f2bf(bf2f(yv[r]) * sigmoidf_(acc[mi][ni][r] + gb));
        }
      }
      SBAR();
    }
  }
}

constexpr float ATHR = 8.f;
__device__ __forceinline__ void partialSM(f32x16& p0, f32x16& p1, float& m_reg, float& mn, float& alpha) {
  constexpr float C = 1.4426950408889634f;
  float pmax = p0[0];
#pragma unroll
  for (int r = 1; r < 16; ++r) pmax = fmaxf(pmax, p0[r]);
#pragma unroll
  for (int r = 0; r < 16; ++r) pmax = fmaxf(pmax, p1[r]);
  { auto rr = __builtin_amdgcn_permlane32_swap(__float_as_uint(pmax), __float_as_uint(pmax), false, false);
    pmax = fmaxf(__uint_as_float(rr[0]), __uint_as_float(rr[1])); }
  if (__builtin_expect(__all(pmax - m_reg <= ATHR), 1)) { mn = m_reg; alpha = 1.f; }
  else { mn = fmaxf(m_reg, pmax); alpha = __builtin_amdgcn_exp2f((m_reg - mn) * C); m_reg = mn; }
  const float mnC = -mn * C;
#pragma unroll
  for (int r = 0; r < 16; ++r) p0[r] = __builtin_amdgcn_exp2f(fmaf(p0[r], C, mnC));
#pragma unroll
  for (int r = 0; r < 16; ++r) p1[r] = __builtin_amdgcn_exp2f(fmaf(p1[r], C, mnC));
}
__device__ __forceinline__ void finishSM(f32x16& p0, f32x16& p1, float alpha, float& l_reg, bf16x8& pa0, bf16x8& pa1, bf16x8& pa2, bf16x8& pa3) {
  float ps = 0;
#pragma unroll
  for (int r = 0; r < 16; ++r) ps += p0[r];
#pragma unroll
  for (int r = 0; r < 16; ++r) ps += p1[r];
  { auto rr = __builtin_amdgcn_permlane32_swap(__float_as_uint(ps), __float_as_uint(ps), false, false);
    ps = __uint_as_float(rr[0]) + __uint_as_float(rr[1]); }
  l_reg = l_reg * alpha + ps;
  PK4(p0, 0, pa0); PK4(p0, 8, pa1); PK4(p1, 0, pa2); PK4(p1, 8, pa3);
}
__device__ __forceinline__ int v_st(int k, int c) { const int kk = (k & ~0xC) | ((k & 4) << 1) | ((k & 8) >> 1); return ((kk >> 3) * 4 + (c >> 5)) * 512 + ((kk & 7) * 32 + (c & 31)) * 2; }
__device__ __forceinline__ int v_rd_base(int lane) { return ((lane & 3) << 3) | (((lane >> 2) & 3) << 6) | (((lane >> 4) & 1) << 5) | (((lane >> 5) & 1) << 8); }
constexpr int v_rd_off(int d0, int ks, int half) { return d0 * 512 + ks * 4096 + half * 2048; }
template <int OFF> __device__ __forceinline__ s16x4 tr_read(int vb) {
  s16x4 r; asm volatile("ds_read_b64_tr_b16 %0, %1 offset:%2" : "=&v"(r) : "v"(vb), "i"(OFF) : "memory"); return r;
}
template <int D0> __device__ __forceinline__ void pv_one(f32x16& od, int vb, bf16x8 pa0, bf16x8 pa1, bf16x8 pa2, bf16x8 pa3) {
#define PKV(L, H) (bf16x8){L[0], L[1], L[2], L[3], H[0], H[1], H[2], H[3]}
  { const s16x4 l0 = tr_read<v_rd_off(D0, 0, 0)>(vb), h0 = tr_read<v_rd_off(D0, 0, 1)>(vb), l1 = tr_read<v_rd_off(D0, 1, 0)>(vb), h1 = tr_read<v_rd_off(D0, 1, 1)>(vb);
    asm volatile("s_waitcnt lgkmcnt(0)" ::: "memory"); SBAR();
    od = MFMA(pa0, PKV(l0, h0), od); od = MFMA(pa1, PKV(l1, h1), od); }
  { const s16x4 l2 = tr_read<v_rd_off(D0, 2, 0)>(vb), h2 = tr_read<v_rd_off(D0, 2, 1)>(vb), l3 = tr_read<v_rd_off(D0, 3, 0)>(vb), h3 = tr_read<v_rd_off(D0, 3, 1)>(vb);
    asm volatile("s_waitcnt lgkmcnt(0)" ::: "memory"); SBAR();
    od = MFMA(pa2, PKV(l2, h2), od); od = MFMA(pa3, PKV(l3, h3), od); }
#undef PKV
}
template <int D0> __device__ __forceinline__ void pv_two(f32x16& oa, f32x16& ob, int vb, bf16x8 a0, bf16x8 a1, bf16x8 a2, bf16x8 a3,
                                                         bf16x8 b0, bf16x8 b1, bf16x8 b2, bf16x8 b3) {
#define PKV(L, H) (bf16x8){L[0], L[1], L[2], L[3], H[0], H[1], H[2], H[3]}
  { const s16x4 l0 = tr_read<v_rd_off(D0, 0, 0)>(vb), h0 = tr_read<v_rd_off(D0, 0, 1)>(vb), l1 = tr_read<v_rd_off(D0, 1, 0)>(vb), h1 = tr_read<v_rd_off(D0, 1, 1)>(vb);
    asm volatile("s_waitcnt lgkmcnt(0)" ::: "memory"); SBAR();
    const bf16x8 v0 = PKV(l0, h0), v1 = PKV(l1, h1);
    oa = MFMA(a0, v0, oa); ob = MFMA(b0, v0, ob); oa = MFMA(a1, v1, oa); ob = MFMA(b1, v1, ob); }
  { const s16x4 l2 = tr_read<v_rd_off(D0, 2, 0)>(vb), h2 = tr_read<v_rd_off(D0, 2, 1)>(vb), l3 = tr_read<v_rd_off(D0, 3, 0)>(vb), h3 = tr_read<v_rd_off(D0, 3, 1)>(vb);
    asm volatile("s_waitcnt lgkmcnt(0)" ::: "memory"); SBAR();
    const bf16x8 v2 = PKV(l2, h2), v3 = PKV(l3, h3);
    oa = MFMA(a2, v2, oa); ob = MFMA(b2, v2, ob); oa = MFMA(a3, v3, oa); ob = MFMA(b3, v3, ob); }
#undef PKV
}
constexpr int ATT_KB = 8192, ATT_VB = 16384, NTILE = SEQ / 64;
__device__ __forceinline__ void att_qkt(f32x16& p0, f32x16& p1, const char* Kb, const bf16x8 (&qr)[4], int koff, int ksw, int hi) {
  p0 = f32x16{}; p1 = f32x16{};
#pragma unroll
  for (int d0 = 0; d0 < 4; ++d0) {
    const int co = ((d0 * 2 + hi) ^ ksw) << 4;
    const bf16x8 b0 = *(const bf16x8*)(Kb + koff + co);
    const bf16x8 b1 = *(const bf16x8*)(Kb + koff + 4096 + co);
    p0 = MFMA(b0, qr[d0], p0); p1 = MFMA(b1, qr[d0], p1);
  }
}
__device__ __forceinline__ void sm_fixed(f32x16& p0, f32x16& p1, float mC, float& l_reg, bf16x8& pa0, bf16x8& pa1, bf16x8& pa2, bf16x8& pa3) {
  constexpr float C = 1.4426950408889634f;
#pragma unroll
  for (int r = 0; r < 16; ++r) p0[r] = __builtin_amdgcn_exp2f(fmaf(p0[r], C, -mC));
#pragma unroll
  for (int r = 0; r < 16; ++r) p1[r] = __builtin_amdgcn_exp2f(fmaf(p1[r], C, -mC));
  float ps = 0;
#pragma unroll
  for (int r = 0; r < 16; ++r) ps += p0[r];
#pragma unroll
  for (int r = 0; r < 16; ++r) ps += p1[r];
  { auto rr = __builtin_amdgcn_permlane32_swap(__float_as_uint(ps), __float_as_uint(ps), false, false);
    ps = __uint_as_float(rr[0]) + __uint_as_float(rr[1]); }
  l_reg += ps;
#define PK4N(PV, BASE, OUT) do { u32x4 w_ = {cvtpk(PV[BASE + 0], PV[BASE + 1]), cvtpk(PV[BASE + 2], PV[BASE + 3]), \
    cvtpk(PV[BASE + 4], PV[BASE + 5]), cvtpk(PV[BASE + 6], PV[BASE + 7])}; OUT = *reinterpret_cast<bf16x8*>(&w_); } while (0)
  PK4N(p0, 0, pa0); PK4N(p0, 8, pa1); PK4N(p1, 0, pa2); PK4N(p1, 8, pa3);
#undef PK4N
}
__device__ __forceinline__ float sumsq8(bf16x8 v) { float s = 0.f;
#pragma unroll
  for (int q = 0; q < 8; ++q) { const float f = bf2f((u16)v[q]); s += f * f; } return s; }
__device__ __forceinline__ void att_qkt_p(f32x16& p0, f32x16& p1, const char* Kb, const bf16x8 (&qr)[2], const char* Qp, int koff, int ksw, int hi) {
  p0 = f32x16{}; p1 = f32x16{};
#pragma unroll
  for (int d0 = 0; d0 < 4; ++d0) {
    const int co = ((d0 * 2 + hi) ^ ksw) << 4;
    const bf16x8 b0 = *(const bf16x8*)(Kb + koff + co);
    const bf16x8 b1 = *(const bf16x8*)(Kb + koff + 4096 + co);
    const bf16x8 qd = d0 < 2 ? qr[d0 & 1] : *(const bf16x8*)(Qp + (d0 - 2) * 4096);
    p0 = MFMA(b0, qd, p0); p1 = MFMA(b1, qd, p1);
  }
}
__device__ __forceinline__ void attn_item(const P& p, int layer, int item, char* lds) {
  const int tid = ltid(), wid = tid >> 6, lane = tid & 63, r32 = lane & 31, hi = lane >> 5;
  const int qb = item & 63, h = (item >> 6) & 3, b = item >> 8;
  const u16* z = (const u16*)(p.ws + OFF_Z);
  const long tokb = (long)b * SEQ, tokq = tokb + qb * 128;
  constexpr int STG = 2 * ATT_KB + ATT_VB;
  float* wsf = (float*)(lds + 2 * STG) + wid * 64;
  float* li_l = wsf; float* al_l = wsf + 32;
  const int vb0 = (int)(uintptr_t)(lds + 2 * ATT_KB) + v_rd_base(lane);
  const int koff = r32 * 128, ksw = (r32 >> 1) & 7;
  const unsigned k_src = (tid >> 3) * ZC + (((tid & 7) ^ ((tid >> 4) & 7)) << 3);
  const int v_kl = (tid & 31) >> 2;
  const unsigned v_src = (v_kl | ((tid >> 7) << 3)) * ZC + ((tid >> 5) & 3) * 32 + (tid & 3) * 8;
  char* lw = lds + tid * 16;
  const float lam = ((const float*)(p.ws + OFF_LAM))[layer];
  const u16* Kg = z + tokb * ZC + C_DAK + h * 128; const u16* Vg = z + tokb * ZC + C_DAV + h * 128;
  bf16x8 q1[4], q2[2];
  char* Qp = lds + 2 * STG + 1024 + tid * 16;
#pragma unroll
  for (int d0 = 0; d0 < 4; ++d0) q1[d0] = *(const bf16x8*)(z + (tokq + wid * 32 + r32) * ZC + h * 128 + d0 * 16 + hi * 8);
#pragma unroll
  for (int d0 = 0; d0 < 2; ++d0) q2[d0] = *(const bf16x8*)(z + (tokq + wid * 32 + r32) * ZC + h * 128 + 64 + d0 * 16 + hi * 8);
  __syncthreads();
  float qs1 = 0.f, qs2 = 0.f;
#pragma unroll
  for (int d0 = 0; d0 < 4; ++d0) qs1 += sumsq8(q1[d0]);
#pragma unroll
  for (int d0 = 0; d0 < 2; ++d0) qs2 += sumsq8(q2[d0]);
#pragma unroll
  for (int d0 = 2; d0 < 4; ++d0) { const bf16x8 t = *(const bf16x8*)(z + (tokq + wid * 32 + r32) * ZC + h * 128 + 64 + d0 * 16 + hi * 8);
    qs2 += sumsq8(t); *(bf16x8*)(Qp + (d0 - 2) * 4096) = t; }
  { auto rr = __builtin_amdgcn_permlane32_swap(__float_as_uint(qs1), __float_as_uint(qs1), false, false); qs1 = __uint_as_float(rr[0]) + __uint_as_float(rr[1]); }
  { auto rr = __builtin_amdgcn_permlane32_swap(__float_as_uint(qs2), __float_as_uint(qs2), false, false); qs2 = __uint_as_float(rr[0]) + __uint_as_float(rr[1]); }
  float mC1, mC2;
  { const float* kmx = (const float*)(p.ws + OFF_KMX) + (size_t)((b * 4 + h) * 2) * 128;
    float k1 = fmaxf(kmx[lane], kmx[64 + lane]), k2 = fmaxf(kmx[128 + lane], kmx[192 + lane]);
#pragma unroll
    for (int o = 32; o >= 1; o >>= 1) { k1 = fmaxf(k1, __shfl_xor(k1, o)); k2 = fmaxf(k2, __shfl_xor(k2, o)); }
    mC1 = sqrtf(qs1 * k1) * 1.4426950408889634f; mC2 = sqrtf(qs2 * k2) * 1.4426950408889634f; }
  float l1 = 0.f, l2 = 0.f;
  f32x16 o1[4], o2[4];
#pragma unroll
  for (int d = 0; d < 4; ++d) { o1[d] = f32x16{}; o2[d] = f32x16{}; }
#define ISSUE_T(t, sl) do { char* S_ = lw + (sl) * STG; \
    _Pragma("unroll") for (int i_ = 0; i_ < 2; ++i_) { glds16(Kg + (long)((t) * 64 + 32 * i_) * ZC + k_src, S_ + i_ * 4096); \
                                                        glds16(Kg + 64 + (long)((t) * 64 + 32 * i_) * ZC + k_src, S_ + ATT_KB + i_ * 4096); } \
    _Pragma("unroll") for (int i_ = 0; i_ < 4; ++i_) glds16(Vg + (long)((t) * 64 + 16 * i_) * ZC + v_src, S_ + 2 * ATT_KB + i_ * 4096); } while (0)
#define RESC(a, O) do { if (__any((a) < 1.f)) { if (hi == 0) al_l[r32] = (a); asm volatile("s_waitcnt lgkmcnt(0)" ::: "memory"); \
    _Pragma("unroll") for (int d_ = 0; d_ < 4; ++d_) _Pragma("unroll") for (int r_ = 0; r_ < 16; ++r_) O[d_][r_] *= al_l[crow(r_, hi)]; } } while (0)
#define MAPSTEP(QKT, MC, L, PA0, PA1, PA2, PA3) do { f32x16 p0, p1; \
    QKT; \
    sm_fixed(p0, p1, MC, L, PA0, PA1, PA2, PA3); } while (0)
  __syncthreads();
  ISSUE_T(0, 0);
  for (int j = 0; j < NTILE; ++j) {
    asm volatile("s_waitcnt vmcnt(0)" ::: "memory"); __syncthreads();
    if (j + 1 < NTILE) ISSUE_T(j + 1, (j + 1) & 1);
    const char* S = lds + (j & 1) * STG;
    const int vb = vb0 + (j & 1) * STG;
    bf16x8 pa0, pa1, pa2, pa3, pb0, pb1, pb2, pb3;
    MAPSTEP(att_qkt(p0, p1, S, q1, koff, ksw, hi), mC1, l1, pa0, pa1, pa2, pa3);
    SBAR();
    MAPSTEP(att_qkt_p(p0, p1, S + ATT_KB, q2, Qp, koff, ksw, hi), mC2, l2, pb0, pb1, pb2, pb3);
    SBAR();
    pv_two<0>(o1[0], o2[0], vb, pa0, pa1, pa2, pa3, pb0, pb1, pb2, pb3); pv_two<1>(o1[1], o2[1], vb, pa0, pa1, pa2, pa3, pb0, pb1, pb2, pb3);
    pv_two<2>(o1[2], o2[2], vb, pa0, pa1, pa2, pa3, pb0, pb1, pb2, pb3); pv_two<3>(o1[3], o2[3], vb, pa0, pa1, pa2, pa3, pb0, pb1, pb2, pb3);
  }
#undef MAPSTEP
#undef RESC
#undef ISSUE_T
  float r1[16], r2[16];
  if (hi == 0) li_l[r32] = l1;
  asm volatile("s_waitcnt lgkmcnt(0)" ::: "memory");
#pragma unroll
  for (int r = 0; r < 16; ++r) r1[r] = 1.f / li_l[crow(r, hi)];
  asm volatile("s_waitcnt lgkmcnt(0)" ::: "memory");
  if (hi == 0) li_l[r32] = l2;
  asm volatile("s_waitcnt lgkmcnt(0)" ::: "memory");
#pragma unroll
  for (int r = 0; r < 16; ++r) r2[r] = lam / li_l[crow(r, hi)];
  const int oz = opq();
  const float gsc = ((const float*)(p.ws + OFF_LAM))[2 + layer];
  float sg[4];
#pragma unroll
  for (int d = 0; d < 4; ++d) sg[d] = p.subln[layer * 128 + d * 32 + r32] * gsc;
  u16* ymix = (u16*)(p.ws + OFF_YMIX);
  const unsigned yb = (unsigned)(tokq + wid * 32 + 4 * hi + oz) * 1024 + h * 128 + r32;
#pragma unroll
  for (int r = 0; r < 16; ++r) {
    float v[4]; float ss = 0.f;
#pragma unroll
    for (int d = 0; d < 4; ++d) { v[d] = o1[d][r] * r1[r] - o2[d][r] * r2[r]; ss += v[d] * v[d]; }
    ss = half_sum32(ss);
    const float rs = rsqrtf(ss * (1.f / 128.f) + 1e-6f);
#pragma unroll
    for (int d = 0; d < 4; ++d) ymix[yb + (unsigned)((r & 3) + 8 * (r >> 2)) * 1024 + d * 32] = f2bf(v[d] * rs * sg[d]);
    if ((r & 3) == 3) SBAR();
  }
}

__device__ __forceinline__ void phase_wout(const P& p, int layer, char* lds) {
  const u16* ym = (const u16*)(p.ws + OFF_YMIX); const u16* wt = (const u16*)(p.ws + OFF_WOUT + layer * SZ_WOUT);
  const u16* xbr = (const u16*)(p.ws + OFF_XB);
  const int lane = ltid() & 63, wid = ltid() >> 6, wr = wid >> 1, wc = wid & 1, r32 = lane & 31, hi = lane >> 5;
  int tm, tn;
  for (int it = 0; tile_at(it, 256, 8, tm, tn); ++it) {
    f32x16 acc[2][2] = {};
    LdBf al{ym + (long)tm * 128 * 1024, 1024}, bl{wt + (long)tn * 128 * 1024, 1024};
    gemm_plain(acc, al, bl, 1024, lds);
    const unsigned rb = (unsigned)(tm * 128 + wr * 64 + 4 * hi + opq());
    _Float16* pre1 = (_Float16*)(p.ws + OFF_PRE1);
#pragma unroll
    for (int mi = 0; mi < 2; ++mi) {
      float xr[2][16];
      if (layer == 0) {
#pragma unroll
        for (int ni = 0; ni < 2; ++ni)
#pragma unroll
          for (int r = 0; r < 16; ++r) xr[ni][r] = p.x[(rb + mi * 32 + (r & 3) + 8 * (r >> 2)) * DM + tn * 128 + wc * 64 + ni * 32 + r32];
      } else {
#pragma unroll
        for (int ni = 0; ni < 2; ++ni)
#pragma unroll
          for (int r = 0; r < 16; ++r) xr[ni][r] = bf2f(xbr[(rb + mi * 32 + (r & 3) + 8 * (r >> 2)) * DM + tn * 128 + wc * 64 + ni * 32 + r32]);
      }
#pragma unroll
      for (int ni = 0; ni < 2; ++ni)
#pragma unroll
        for (int r = 0; r < 16; ++r) {
          const unsigned row = rb + mi * 32 + (r & 3) + 8 * (r >> 2); const unsigned col = tn * 128 + wc * 64 + ni * 32 + r32;
          pre1[row * DM + col] = (_Float16)(ALPHA * xr[ni][r] + acc[mi][ni][r]);
        }
      SBAR();
    }
  }
}
__device__ __forceinline__ float4 ldh4(const _Float16* q) {
  typedef _Float16 h4_ __attribute__((ext_vector_type(4)));
  const h4_ t = __builtin_nontemporal_load((const h4_*)q); return float4{(float)t[0], (float)t[1], (float)t[2], (float)t[3]};
}
__device__ __forceinline__ void phase_ln(const P& p, const float* g, const float* bta, const float* pconv, bool write_f32, const _Float16* pre) {
  const int lane = ltid() & 63, wid = ltid() >> 6;
  u16* xb = (u16*)(p.ws + OFF_XB);
  if (pconv) {
    u16* pb = (u16*)(p.ws + OFF_PB);
    for (long i = (long)blockIdx.x * NTHR + ltid(); i < (long)TT * 256 / 8; i += (long)gridDim.x * NTHR) {
      const float4* q = (const float4*)(pconv + i * 8); float4 a = ntld4(q), b = ntld4(q + 1);
      u32x4 w = {cvtpk(a.x, a.y), cvtpk(a.z, a.w), cvtpk(b.x, b.y), cvtpk(b.z, b.w)};
      *(u32x4*)(pb + i * 8) = w; }
  }
  const long rstride = (long)gridDim.x * 4;
  float4 gg4[4], bb4[4];
#pragma unroll
  for (int i = 0; i < 4; ++i) { gg4[i] = *(const float4*)(g + (i * 64 + lane) * 4); bb4[i] = *(const float4*)(bta + (i * 64 + lane) * 4); }
  typedef _Float16 h4p_ __attribute__((ext_vector_type(4)));
  h4p_ nx[2][4];
  { const long r0 = (long)blockIdx.x * 4 + wid, r1 = r0 + rstride;
#pragma unroll
    for (int i = 0; i < 4; ++i) { nx[0][i] = r0 < TT ? __builtin_nontemporal_load((const h4p_*)(pre + r0 * DM + (i * 64 + lane) * 4)) : h4p_{0, 0, 0, 0};
                                  nx[1][i] = r1 < TT ? __builtin_nontemporal_load((const h4p_*)(pre + r1 * DM + (i * 64 + lane) * 4)) : h4p_{0, 0, 0, 0}; } }
  for (long row0 = (long)blockIdx.x * 4 + wid; row0 < TT; row0 += 2 * rstride) {
    const long row1 = row0 + rstride; const bool two = row1 < TT;
    float4 v[2][4]; float s[2] = {0.f, 0.f};
#pragma unroll
    for (int u = 0; u < 2; ++u)
#pragma unroll
      for (int i = 0; i < 4; ++i) { v[u][i] = float4{(float)nx[u][i][0], (float)nx[u][i][1], (float)nx[u][i][2], (float)nx[u][i][3]};
        s[u] += v[u][i].x + v[u][i].y + v[u][i].z + v[u][i].w; }
    { const long n0 = row0 + 2 * rstride, n1 = n0 + rstride;
      if (n0 < TT) {
#pragma unroll
        for (int i = 0; i < 4; ++i) nx[0][i] = __builtin_nontemporal_load((const h4p_*)(pre + n0 * DM + (i * 64 + lane) * 4));
      }
      if (n1 < TT) {
#pragma unroll
        for (int i = 0; i < 4; ++i) nx[1][i] = __builtin_nontemporal_load((const h4p_*)(pre + n1 * DM + (i * 64 + lane) * 4));
      } }
#pragma unroll
    for (int u = 0; u < 2; ++u) {
      if (u == 1 && !two) break;
      const long row = u ? row1 : row0;
      const float mu = wave_sum(s[u]) * (1.f / 1024.f);
      float q = 0.f;
#pragma unroll
      for (int i = 0; i < 4; ++i) { v[u][i].x -= mu; v[u][i].y -= mu; v[u][i].z -= mu; v[u][i].w -= mu; q += v[u][i].x * v[u][i].x + v[u][i].y * v[u][i].y + v[u][i].z * v[u][i].z + v[u][i].w * v[u][i].w; }
      const float rs = rsqrtf(wave_sum(q) * (1.f / 1024.f) + 1e-5f);
#pragma unroll
      for (int i = 0; i < 4; ++i) {
        const int c = (i * 64 + lane) * 4;
        const float4 gg = gg4[i], bb = bb4[i];
        float4 y = {v[u][i].x * rs * gg.x + bb.x, v[u][i].y * rs * gg.y + bb.y, v[u][i].z * rs * gg.z + bb.z, v[u][i].w * rs * gg.w + bb.w};
        if (write_f32) *(float4*)(p.out + row * DM + c) = y;
        u32x2 w = {cvtpk(y.x, y.y), cvtpk(y.z, y.w)};
        *(u32x2*)(xb + row * DM + c) = w;
      }
    }
  }
}
__device__ __forceinline__ void phase_ffn_up(const P& p, int layer, char* lds) {
  const u16* xb = (const u16*)(p.ws + OFF_XB); const u16* wt = (const u16*)(p.ws + OFF_WUP + layer * SZ_WUP);
  u16* aout = (u16*)(p.ws + OFF_A);
  const int tid = ltid(), lane = tid & 63, wid = tid >> 6, wr = wid >> 1, wc = wid & 1, r32 = lane & 31, hi = lane >> 5;
  float* G = (float*)lds;
  int tm, tn;
  for (int it = 0; tile_at(it, 256, 44, tm, tn); ++it) {
    f32x16 acc[2][2] = {}; f32x16 hacc = {};
    const long r0 = (long)tm * 128;
    const bool top0 = (r0 % SEQ) == 0, bot0 = ((r0 + 128) % SEQ) == 0;
    LdBf al{xb + r0 * DM, DM}; LdBsplit bl{wt, DM, tn * 64};
    const u16* zr = (const u16*)(p.ws + OFF_ZERO);
    const u16* h0 = top0 ? zr : xb + (r0 - 1) * DM; const u16* h1 = bot0 ? zr : xb + (r0 + 128) * DM;
    gemm_core<true>(acc, hacc, al, bl, DM, lds, h0, h1, wc * 32, 64 + wc * 32);
    __syncthreads();
    const int lb0 = wr * 64 + 4 * hi + opq();
    float* Gc = G + wc * 32 + r32;
#pragma unroll
    for (int mi = 0; mi < 2; ++mi)
#pragma unroll
      for (int r = 0; r < 16; ++r) Gc[(1 + lb0 + mi * 32 + (r & 3) + 8 * (r >> 2)) * 65] = acc[mi][0][r];
    if (hi == 0) { if (wr == 0) Gc[0] = hacc[0]; else Gc[129 * 65] = hacc[1]; }
    __syncthreads();
    const int f = tn * 64 + wc * 32 + r32;
    const float w0 = p.conv_w[(layer * 3 + 0) * DFF + f], w1 = p.conv_w[(layer * 3 + 1) * DFF + f], w2 = p.conv_w[(layer * 3 + 2) * DFF + f];
    const float cb = p.conv_b[layer * DFF + f];
    const unsigned ob = (unsigned)(tm * 128) * DFF + f;
#pragma unroll
    for (int mi = 0; mi < 2; ++mi) {
#pragma unroll
      for (int r = 0; r < 16; r += 2) {
        const int lr = lb0 + mi * 32 + (r & 3) + 8 * (r >> 2);
        const float g0 = w0 * Gc[lr * 65] + w1 * acc[mi][0][r] + w2 * Gc[(lr + 2) * 65] + cb;
        const float g1 = w0 * Gc[(lr + 1) * 65] + w1 * acc[mi][0][r + 1] + w2 * Gc[(lr + 3) * 65] + cb;
        const unsigned w = cvtpk(gelu_t(g0) * acc[mi][1][r], gelu_t(g1) * acc[mi][1][r + 1]);
        aout[ob + (unsigned)lr * DFF] = (u16)w; aout[ob + (unsigned)(lr + 1) * DFF] = (u16)(w >> 16);
      }
      SBAR();
    }
  }
}
__device__ __forceinline__ void phase_ffn_down(const P& p, int layer, char* lds) {
  const u16* xb = (const u16*)(p.ws + OFF_XB); const u16* ab = (const u16*)(p.ws + OFF_A);
  const u16* wd = (const u16*)(p.ws + OFF_WDN + layer * SZ_WDN); const u16* wg = (const u16*)(p.ws + OFF_WGATE + layer * SZ_WGATE);
  const u16* wp = (const u16*)(p.ws + OFF_WPLE + layer * SZ_WPLE);
  const u16* pb = (const u16*)(p.ws + OFF_PB);
  const int lane = ltid() & 63, wid = ltid() >> 6, wr = wid >> 1, wc = wid & 1, r32 = lane & 31, hi = lane >> 5;
  int tm, tn;
  for (int it = 0; tile_at(it, 256, 8, tm, tn); ++it) {
    f32x16 acc[2][2] = {};
    { LdBf al{xb + (long)tm * 128 * DM, DM}, bl{wg + (long)tn * 128 * DM, DM}; gemm_plain(acc, al, bl, DM, lds); }
#pragma unroll
    for (int mi = 0; mi < 2; ++mi)
#pragma unroll
      for (int ni = 0; ni < 2; ++ni)
#pragma unroll
        for (int r = 0; r < 16; ++r) acc[mi][ni][r] = sigmoidf_(acc[mi][ni][r]);
    f32x16 acc2[2][2] = {};
    { LdBf al{pb + (long)tm * 128 * 256, 256}; LdBf bl{wp + (long)tn * 128 * 256, 256}; gemm_plain(acc2, al, bl, 256, lds); }
#pragma unroll
    for (int mi = 0; mi < 2; ++mi)
#pragma unroll
      for (int ni = 0; ni < 2; ++ni) acc[mi][ni] = acc[mi][ni] * acc2[mi][ni];
    { LdBf al{ab + (long)tm * 128 * DFF, DFF}, bl{wd + (long)tn * 128 * DFF, DFF}; gemm_plain(acc, al, bl, DFF, lds); }
    const unsigned rb = (unsigned)(tm * 128 + wr * 64 + 4 * hi + opq());
#pragma unroll
    for (int mi = 0; mi < 2; ++mi) {
#pragma unroll
      for (int ni = 0; ni < 2; ++ni)
#pragma unroll
        for (int r = 0; r < 16; ++r) {
          const unsigned row = rb + mi * 32 + (r & 3) + 8 * (r >> 2); const unsigned col = tn * 128 + wc * 64 + ni * 32 + r32;
          ((_Float16*)(p.ws + OFF_PRE2))[row * DM + col] = (_Float16)(ALPHA * bf2f(xb[row * DM + col]) + acc[mi][ni][r]);
        }
      SBAR();
    }
  }
}

#define XB_TMO      128
#define XB_XCNT(j)  (256  + 64 * (j))
#define XB_XSUB(j)  (1280 + 64 * (j))
#define XB_XGEN(j)  (2304 + 64 * (j))
#define XB_TOP      3328
#define XB_TOPGEN   3392
#define XB_SPIN_CAP (1u << 20)
#define LAS __attribute__((address_space(3)))
__device__ __forceinline__ unsigned xb_ld(unsigned* p)              { return __hip_atomic_load(p, __ATOMIC_RELAXED, __HIP_MEMORY_SCOPE_AGENT); }
__device__ __forceinline__ unsigned xb_add(unsigned* p, unsigned v) { return __hip_atomic_fetch_add(p, v, __ATOMIC_RELAXED, __HIP_MEMORY_SCOPE_AGENT); }
__device__ __forceinline__ unsigned xb_xcc_id() { return (unsigned)__builtin_amdgcn_s_getreg((3 << 11) | 20) & 0xFu; }
#define XB_SPIN(cond, bar) do { unsigned _sp = 0; while (cond) { __builtin_amdgcn_s_sleep(1); \
    if ((++_sp & 255u) == 0u) { if (xb_ld(&(bar)[XB_TMO])) break; if (_sp > XB_SPIN_CAP) { atomicAdd(&(bar)[XB_TMO], 1u); break; } } } } while (0)
struct XcdBarrier { unsigned* bar; unsigned x; volatile LAS unsigned* st; };
__device__ __forceinline__ XcdBarrier xcd_barrier_post(unsigned* bar, volatile LAS unsigned* st) {
  XcdBarrier b; b.bar = bar; b.x = xb_xcc_id(); b.st = st;
  if (threadIdx.x == 0) (void)xb_add(&bar[XB_XCNT(b.x)], 1u);
  return b;
}
__device__ __forceinline__ void xcd_barrier_complete(unsigned* bar, unsigned x, unsigned& nloc, unsigned& nx) {
  const unsigned G = gridDim.x * gridDim.y * gridDim.z;
  unsigned sum, cnt, mine, sp = 0u;
  for (;;) {
    sum = 0u; cnt = 0u; mine = 0u;
#pragma unroll
    for (unsigned j = 0; j < 16; ++j) { const unsigned c = xb_ld(&bar[XB_XCNT(j)]); sum += c; cnt += (c > 0u) ? 1u : 0u; mine = (j == x) ? c : mine; }
    if (sum == G) break;
    __builtin_amdgcn_s_sleep(1);
    if ((++sp & 255u) == 0u) { if (xb_ld(&bar[XB_TMO])) break; if (sp > XB_SPIN_CAP) { atomicAdd(&bar[XB_TMO], 1u); break; } }
  }
  nloc = mine > 0u ? mine : 1u; nx = cnt > 0u ? cnt : 1u;
}
__device__ __forceinline__ void xcd_barrier(const XcdBarrier& b) {
  asm volatile("s_waitcnt vmcnt(0)" ::: "memory");
  __syncthreads();
  if (threadIdx.x == 0) {
    unsigned* bar = b.bar;
    __builtin_amdgcn_s_waitcnt(0);
    unsigned nloc = b.st[0], nx = b.st[1];
    if (nloc == 0u) { xcd_barrier_complete(bar, b.x, nloc, nx); b.st[0] = nloc; b.st[1] = nx; }
    const unsigned old = xb_add(&bar[XB_XSUB(b.x)], 1u);
    const unsigned gen = old / nloc;
    if (old + 1u == (gen + 1u) * nloc) {
      __builtin_amdgcn_fence(__ATOMIC_RELEASE, "agent");
      asm volatile("s_waitcnt vmcnt(0)" ::: "memory");
      const unsigned og = xb_add(&bar[XB_TOP], 1u);
      const unsigned tg = og / nx;
      if (og + 1u == (tg + 1u) * nx) xb_add(&bar[XB_TOPGEN], 1u);
      else XB_SPIN(xb_ld(&bar[XB_TOPGEN]) == tg, bar);
      __builtin_amdgcn_fence(__ATOMIC_ACQUIRE, "agent");
      xb_add(&bar[XB_XGEN(b.x)], 1u);
      asm volatile("s_waitcnt vmcnt(0)" ::: "memory");
    } else {
      XB_SPIN(xb_ld(&bar[XB_XGEN(b.x)]) == gen, bar);
      __builtin_amdgcn_fence(__ATOMIC_ACQUIRE, "agent");
      asm volatile("s_waitcnt vmcnt(0)" ::: "memory");
    }
  }
  __syncthreads();
}

constexpr int NSUB = 10, NPH = 1 + 2 * NSUB;
template <bool WITH_P0>
__device__ __forceinline__ void run_phase(const P& pin, int ph, char* lds) {
  typedef const __attribute__((address_space(4))) P* KP;
  KP kp = (KP)__builtin_amdgcn_kernarg_segment_ptr();
  asm volatile("" : "+s"(kp));
  P p;
  p.x = kp->x;
  p.p = kp->p;
  p.pos = kp->pos;
  p.w_in = kp->w_in;
  p.lq1 = kp->lq1;
  p.lk1 = kp->lk1;
  p.lq2 = kp->lq2;
  p.lk2 = kp->lk2;
  p.subln = kp->subln;
  p.gn_g = kp->gn_g;
  p.gn_b = kp->gn_b;
  p.A_re = kp->A_re;
  p.A_im = kp->A_im;
  p.log_dt = kp->log_dt;
  p.B_re = kp->B_re;
  p.B_im = kp->B_im;
  p.C_re = kp->C_re;
  p.C_im = kp->C_im;
  p.Dp = kp->Dp;
  p.glu_w = kp->glu_w;
  p.glu_b = kp->glu_b;
  p.w_out = kp->w_out;
  p.ln1g = kp->ln1g;
  p.ln1b = kp->ln1b;
  p.w_up = kp->w_up;
  p.conv_w = kp->conv_w;
  p.conv_b = kp->conv_b;
  p.w_down = kp->w_down;
  p.ple_w = kp->ple_w;
  p.gate_w = kp->gate_w;
  p.ln2g = kp->ln2g;
  p.ln2b = kp->ln2b;
  p.out = kp->out;
  p.ws = kp->ws;

  if (ph == 0) { if (WITH_P0) phase0(p, lds); return; }
  const int layer = (ph - 1) / NSUB, s = (ph - 1) % NSUB;
  const int bid = blockIdx.x, nb = gridDim.x;
  switch (s) {
    case 0: phase_z(p, layer, lds); if (layer == 0) s5_build_ktab_F(p); break;
    case 1:
      for (int t = bid; t < 1024; t += nb) ret_kv_item(p, t, lds);
      for (int t = bid; t < 256; t += nb) s5_state_tile(p, layer, t, lds);
      if (layer == 0) s5_build_M(p);
      break;
    case 2: s5_scan(p, layer); ret_scan(p); break;
    case 3: {
      const int x = bid & 7, lb = bid >> 3, nlb = nb >> 3;
      for (int t = bid; t < 1024; t += nb) ret_out_item(p, layer, t, lds);
      for (int t = bid; t < 512; t += nb) s5_out_tile(p, layer, t, lds);
      for (int i = lb; i < 128; i += nlb) attn_item(p, layer, (i >> 6) * 512 + x * 64 + (i & 63), lds);
    } break;
    case 4: phase_glu(p, layer, lds); break;
    case 5: phase_wout(p, layer, lds); break;
    case 6: phase_ln(p, p.ln1g + layer * DM, p.ln1b + layer * DM, p.p + (size_t)layer * TT * 256, false, (const _Float16*)(p.ws + OFF_PRE1)); break;
    case 7: phase_ffn_up(p, layer, lds); break;
    case 8: phase_ffn_down(p, layer, lds); break;
    default: phase_ln(p, p.ln2g + layer * DM, p.ln2b + layer * DM, nullptr, layer == 1, (const _Float16*)(p.ws + OFF_PRE2)); break;
  }
}

__global__ void __launch_bounds__(NTHR, 2) mega(P p, int ph0, int ph1) {
  extern __shared__ __attribute__((aligned(16))) char lds[];
  if (ph1 < 0) cg::this_grid().sync();
  volatile LAS unsigned* st = (volatile LAS unsigned*)(lds + LDS_BYTES);
  if (threadIdx.x == 0) { st[0] = 0u; st[1] = 0u; st[2] = 0u; st[3] = 0u; }
  __syncthreads();
  const XcdBarrier xb = xcd_barrier_post((unsigned*)(p.ws + OFF_BAR), st);
#define GSYNC() xcd_barrier(xb)
  for (int i = 0; i < PROBE_SYNCS; ++i) GSYNC();
  int ph = ph0;
  if (ph == 0) {
    const int nrep0 = 1 + ((PROBE_MASK >> NSUB) & 1);
    for (int rep = 0; rep < nrep0; ++rep) { run_phase<true>(p, 0, lds); if (rep + 1 < nrep0 || 1 < ph1) GSYNC(); }
    ph = 1;
  }
  for (; ph < ph1; ++ph) {
    const int nrep = 1 + ((PROBE_MASK >> ((ph - 1) % NSUB)) & 1);
    for (int rep = 0; rep < nrep; ++rep) {
      run_phase<false>(p, ph, lds);
      if (rep + 1 < nrep || ph + 1 < ph1) GSYNC();
    }
  }
#undef GSYNC
}

extern "C" void kernel_launch(void* const* d_in, const int* in_sizes, int n_in, void* d_out, int out_size,
                              void* d_ws, size_t ws_size, hipStream_t stream) {
  static int grid_blocks = 0;
  if (!grid_blocks) {
    int dev = 0, cus = 0, per_cu = 0;
    (void)hipGetDevice(&dev);
    (void)hipDeviceGetAttribute(&cus, hipDeviceAttributeMultiprocessorCount, dev);
    (void)hipFuncSetAttribute((const void*)mega, hipFuncAttributeMaxDynamicSharedMemorySize, LDS_TOTAL);
    (void)hipOccupancyMaxActiveBlocksPerMultiprocessor(&per_cu, mega, NTHR, LDS_TOTAL);
    if (per_cu > 2) per_cu = 2;
    if (per_cu < 1) per_cu = 1;
    grid_blocks = cus * per_cu;
    grid_blocks -= grid_blocks % 8;
    if (ws_size < WS_NEED) fprintf(stderr, "kernel_launch: workspace too small: %zu < %zu\n", ws_size, WS_NEED);
  }
  if (ws_size < WS_NEED || n_in < 32) return;
  P p{};
  p.x = (const float*)d_in[0]; p.p = (const float*)d_in[1]; p.pos = (const int*)d_in[2];
  p.w_in = (const float*)d_in[3]; p.lq1 = (const float*)d_in[4]; p.lk1 = (const float*)d_in[5]; p.lq2 = (const float*)d_in[6];
  p.lk2 = (const float*)d_in[7]; p.subln = (const float*)d_in[8]; p.gn_g = (const float*)d_in[9]; p.gn_b = (const float*)d_in[10];
  p.A_re = (const float*)d_in[11]; p.A_im = (const float*)d_in[12]; p.log_dt = (const float*)d_in[13]; p.B_re = (const float*)d_in[14];
  p.B_im = (const float*)d_in[15]; p.C_re = (const float*)d_in[16]; p.C_im = (const float*)d_in[17]; p.Dp = (const float*)d_in[18];
  p.glu_w = (const float*)d_in[19]; p.glu_b = (const float*)d_in[20]; p.w_out = (const float*)d_in[21]; p.ln1g = (const float*)d_in[22];
  p.ln1b = (const float*)d_in[23]; p.w_up = (const float*)d_in[24]; p.conv_w = (const float*)d_in[25]; p.conv_b = (const float*)d_in[26];
  p.w_down = (const float*)d_in[27]; p.ple_w = (const float*)d_in[28]; p.gate_w = (const float*)d_in[29]; p.ln2g = (const float*)d_in[30];
  p.ln2b = (const float*)d_in[31];
  p.out = (float*)d_out; p.ws = (char*)d_ws;
#if MK_LAUNCHES == 1
  int ph0 = 0, ph1 = NPH;
  void* args[] = {&p, &ph0, &ph1};
  (void)hipMemsetAsync((char*)d_ws + OFF_BAR, 0, SZ_BAR, stream);
  hipError_t e = hipLaunchCooperativeKernel((void*)mega, dim3(grid_blocks), dim3(NTHR), args, LDS_TOTAL, stream);
  if (e != hipSuccess) fprintf(stderr, "cooperative launch failed: %s (grid %d)\n", hipGetErrorString(e), grid_blocks);
#else
  for (int ph = 0; ph < NPH; ++ph) hipLaunchKernelGGL(mega, dim3(grid_blocks), dim3(NTHR), LDS_TOTAL, stream, p, ph, ph + 1);
#endif
}
```

```cpp
#include <hip/hip_runtime.h>
#include <hip/hip_cooperative_groups.h>
#include <cstdio>
#include <cstdint>
namespace cg = cooperative_groups;

typedef unsigned short u16;
using bf16x8 = __attribute__((ext_vector_type(8))) short;
using s16x4  = __attribute__((ext_vector_type(4))) short;
using f32x16 = __attribute__((ext_vector_type(16))) float;
using u32x4  = __attribute__((ext_vector_type(4))) unsigned;
using u32x2  = __attribute__((ext_vector_type(2))) unsigned;

#ifndef PROBE_MASK
#define PROBE_MASK 0
#endif
#ifndef PROBE_SYNCS
#define PROBE_SYNCS 0
#endif
#ifndef MK_LAUNCHES
#define MK_LAUNCHES 1
#endif

constexpr int TT = 32768, SEQ = 8192, DM = 1024, ZC = 2816, DFF = 2816;
constexpr int C_DAK = 512, C_DAV = 1024, C_RQ = 1536, C_RK = 1792, C_RV = 2048, C_RG = 2304, C_U = 2560;
constexpr float ALPHA = 1.4142135623730951f;
constexpr int NTHR = 256;
constexpr int LDS_BYTES = 74752, LDS_TOTAL = LDS_BYTES + 16;

constexpr size_t al256(size_t x) { return (x + 255) / 256 * 256; }
constexpr size_t SZ_WIN = (size_t)2816 * 1024 * 2, SZ_WOUT = (size_t)1024 * 1024 * 2, SZ_WUP = (size_t)5632 * 1024 * 2,
                 SZ_WDN = (size_t)1024 * 2816 * 2, SZ_WPLE = (size_t)1024 * 256 * 2, SZ_WGATE = (size_t)1024 * 1024 * 2,
                 SZ_WGLU = (size_t)256 * 256 * 2;
constexpr size_t SZ_S5M = (size_t)16 * 512 * 768 * 2, SZ_S5F = (size_t)16 * 256 * 512 * 2;
constexpr size_t OFF_WIN = 0;
constexpr size_t OFF_WOUT = OFF_WIN + 2 * SZ_WIN;
constexpr size_t OFF_WUP = OFF_WOUT + 2 * SZ_WOUT;
constexpr size_t OFF_WDN = OFF_WUP + 2 * SZ_WUP;
constexpr size_t OFF_WPLE = OFF_WDN + 2 * SZ_WDN;
constexpr size_t OFF_WGATE = OFF_WPLE + 2 * SZ_WPLE;
constexpr size_t OFF_WGLU = OFF_WGATE + 2 * SZ_WGATE;
constexpr size_t OFF_S5M = OFF_WGLU + 2 * SZ_WGLU;
constexpr size_t OFF_S5F = OFF_S5M + 2 * SZ_S5M;
constexpr size_t OFF_PW = OFF_S5F + 2 * SZ_S5F;
constexpr size_t SZ_PW = (size_t)2 * 2 * 16 * 64 * 33 * 2 * 4;
constexpr size_t OFF_BB = al256(OFF_PW + SZ_PW);
constexpr size_t SZ_BB = (size_t)2 * 2 * 16 * 64 * 16 * 2 * 4;
constexpr size_t OFF_KTAB = al256(OFF_BB + SZ_BB);
constexpr size_t SZ_KTAB = (size_t)2 * 16 * 2 * 32 * 256 * 4;
constexpr size_t OFF_LAM = al256(OFF_KTAB + SZ_KTAB);
constexpr size_t OFF_BAR = OFF_LAM + 256;
constexpr size_t SZ_BAR = 3456 * 4;
constexpr size_t OFF_ZERO = OFF_BAR + SZ_BAR;
constexpr size_t OFF_KMX = OFF_ZERO + 2048;
constexpr size_t OFF_COS = OFF_KMX + 16384;
constexpr size_t OFF_SIN = OFF_COS + (size_t)TT * 32 * 4;
constexpr size_t OFF_XB = OFF_SIN + (size_t)TT * 32 * 4;
constexpr size_t OFF_R1 = OFF_XB + (size_t)TT * 1024 * 2;
constexpr size_t OFF_Z = OFF_R1;
constexpr size_t OFF_YMIX = OFF_Z + (size_t)TT * ZC * 2;
constexpr size_t OFF_YGB = OFF_YMIX + (size_t)TT * 1024 * 2;
constexpr size_t OFF_XEND = OFF_YGB + (size_t)TT * 256 * 2;
constexpr size_t OFF_SINS = OFF_XEND + (size_t)1024 * 16 * 256 * 4;
constexpr size_t OFF_KVT = OFF_SINS + (size_t)1024 * 16 * 256 * 2;
constexpr size_t OFF_KVS = OFF_KVT + (size_t)16 * 64 * 2 * 4096 * 4;
constexpr size_t OFF_R1END = OFF_KVS + (size_t)16 * 64 * 2 * 4096 * 2;
constexpr size_t OFF_PB = OFF_YGB;
constexpr size_t OFF_HALO = OFF_YMIX;
constexpr size_t OFF_PRE1 = OFF_Z;
constexpr size_t OFF_PRE2 = OFF_YMIX;
constexpr size_t OFF_A = OFF_R1;
constexpr size_t WS_NEED = OFF_R1END;

struct P {
  const float *x, *p; const int* pos;
  const float *w_in, *lq1, *lk1, *lq2, *lk2, *subln, *gn_g, *gn_b, *A_re, *A_im, *log_dt, *B_re, *B_im, *C_re, *C_im, *Dp,
      *glu_w, *glu_b, *w_out, *ln1g, *ln1b, *w_up, *conv_w, *conv_b, *w_down, *ple_w, *gate_w, *ln2g, *ln2b;
  float* out; char* ws;
};

__device__ __forceinline__ unsigned cvtpk(float lo, float hi) {
  unsigned r; asm volatile("v_cvt_pk_bf16_f32 %0, %1, %2" : "=v"(r) : "v"(lo), "v"(hi)); return r;
}
__device__ __forceinline__ u16 f2bf(float x) { return (u16)(cvtpk(x, 0.f) & 0xffffu); }
__device__ __forceinline__ float bf2f(u16 v) { return __uint_as_float(((unsigned)v) << 16); }
__device__ __forceinline__ float4 ntld4(const void* q) {
  typedef float f4_ __attribute__((ext_vector_type(4)));
  const f4_ t = __builtin_nontemporal_load((const f4_*)q); return float4{t[0], t[1], t[2], t[3]};
}
__device__ __forceinline__ int crow(int r, int hi) { return (r & 3) + 8 * (r >> 2) + 4 * hi; }
__device__ __forceinline__ float gelu_t(float x) {
  constexpr float c1 = -2.f * 1.4426950408889634f * 0.7978845608028654f, c2 = c1 * 0.044715f;
  const float t = x * fmaf(c2, x * x, c1);
  return x * __builtin_amdgcn_rcpf(1.f + __builtin_amdgcn_exp2f(t));
}
__device__ __forceinline__ float sigmoidf_(float x) { return __builtin_amdgcn_rcpf(1.f + __expf(-x)); }
__device__ __forceinline__ float half_sum32(float v) {
  v += __shfl_xor(v, 16); v += __shfl_xor(v, 8); v += __shfl_xor(v, 4); v += __shfl_xor(v, 2); v += __shfl_xor(v, 1); return v;
}
__device__ __forceinline__ float wave_sum(float v) { v += __shfl_xor(v, 32); return half_sum32(v); }
__device__ __forceinline__ int ltid() { int t = (int)threadIdx.x; asm volatile("" : "+v"(t)); return t; }
__device__ __forceinline__ int opq() { int z = 0; asm volatile("" : "+v"(z)); return z; }
#define SBAR() __builtin_amdgcn_sched_barrier(0)
#define MFMA(a, b, c) __builtin_amdgcn_mfma_f32_32x32x16_bf16(a, b, c, 0, 0, 0)

struct LdBf { const u16* base; long ld;
  __device__ __forceinline__ const u16* ptr(int row, int k) const { return base + (long)row * ld + k; } };
struct LdS5 { const u16* z; const u16* sins; int g; int chunk0;
  __device__ __forceinline__ const u16* ptr(int row, int k) const {
    const long chunk = chunk0 + row;
    return (k < 512) ? z + (chunk * 32 + (k >> 4)) * ZC + C_U + g * 16 + (k & 15) : sins + (chunk * 16 + g) * 256 + (k - 512); } };
struct LdBsplit { const u16* base; long ld; int f0;
  __device__ __forceinline__ const u16* ptr(int row, int k) const {
    const int rr = (row < 64) ? f0 + row : DFF + f0 + row - 64; return base + (long)rr * ld + k; } };
__device__ __forceinline__ void glds16(const void* g, void* l) {
  __builtin_amdgcn_global_load_lds((const __attribute__((address_space(1))) unsigned*)g, (__attribute__((address_space(3))) unsigned*)l, 16, 0, 0);
}

template <bool HALO, class AL, class BL>
__device__ __forceinline__ void gemm_core(f32x16 (&acc)[2][2], f32x16& hacc, const AL& al, const BL& bl, int K, char* lds,
                                          const u16* halo0, const u16* halo1, int brow0, int brow1) {
  constexpr int ABYTES = HALO ? 136 * 128 : 128 * 128, BUF = ABYTES + 16384;
  const int tid = ltid(), lane = tid & 63, wid = tid >> 6, wr = wid >> 1, r32 = lane & 31, hi = lane >> 5;
  const int lrow = tid >> 3, cg = ((tid & 7) ^ ((lrow >> 1) & 7)) * 8;
  const u16* gh = nullptr;
  if (HALO) { const int c = ((lane & 7) ^ ((lane >> 4) & 7)) * 8; gh = ((lane < 8) ? halo0 : halo1) + c; }
  char* lw = lds + tid * 16;
#define ISSUE(k0, bf) do { char* A_ = lw + (bf) * BUF; \
    _Pragma("unroll") for (int i_ = 0; i_ < 4; ++i_) { glds16(al.ptr(lrow + 32 * i_, (k0) + cg), A_ + i_ * 4096); glds16(bl.ptr(lrow + 32 * i_, (k0) + cg), A_ + ABYTES + i_ * 4096); } \
    if (HALO) { if (wid == 0) glds16(gh + (k0), A_ + 16384); } } while (0)
  const int sa = ((wr * 64 + r32) >> 1) & 7, sb0 = ((brow0 + r32) >> 1) & 7, sb1 = ((brow1 + r32) >> 1) & 7, sh = (r32 >> 1) & 7;
  const int oa = (wr * 64 + r32) * 128, ob0 = ABYTES + (brow0 + r32) * 128, ob1 = ABYTES + (brow1 + r32) * 128, oh = (128 + r32) * 128;
  __syncthreads();
  ISSUE(0, 0);
  const int nk = K >> 6;
  for (int kt = 0; kt < nk; ++kt) {
    asm volatile("s_waitcnt vmcnt(0)" ::: "memory");
    __syncthreads();
    if (kt + 1 < nk) ISSUE((kt + 1) * 64, (kt + 1) & 1);
    const char* T = lds + (kt & 1) * BUF;
#pragma unroll
    for (int kk = 0; kk < 4; ++kk) {
      const int c = kk * 2 + hi;
      bf16x8 a0 = *(const bf16x8*)(T + oa + ((c ^ sa) << 4));
      bf16x8 a1 = *(const bf16x8*)(T + oa + 4096 + ((c ^ sa) << 4));
      bf16x8 b0 = *(const bf16x8*)(T + ob0 + ((c ^ sb0) << 4));
      bf16x8 b1 = *(const bf16x8*)(T + ob1 + ((c ^ sb1) << 4));
      acc[0][0] = MFMA(a0, b0, acc[0][0]); acc[0][1] = MFMA(a0, b1, acc[0][1]);
      acc[1][0] = MFMA(a1, b0, acc[1][0]); acc[1][1] = MFMA(a1, b1, acc[1][1]);
      if (HALO) { bf16x8 ah = *(const bf16x8*)(T + oh + ((c ^ sh) << 4)); hacc = MFMA(ah, b0, hacc); }
    }
  }
#undef ISSUE
}
template <class AL, class BL>
__device__ __forceinline__ void gemm_plain(f32x16 (&acc)[2][2], const AL& al, const BL& bl, int K, char* lds) {
  f32x16 dummy = {};
  const int wc = (ltid() >> 6) & 1;
  gemm_core<false>(acc, dummy, al, bl, K, lds, nullptr, nullptr, wc * 64, wc * 64 + 32);
}
__device__ __forceinline__ bool tile_at(int it, int nM, int nN, int& tm, int& tn) {
  const int total = nM * nN, per = (total + 7) / 8, x = blockIdx.x & 7, lb = blockIdx.x >> 3, nlb = gridDim.x >> 3;
  const int i = lb + it * nlb; if (i >= per) return false;
  const int idx = x * per + i; if (idx >= total) return false;
  const int grp = idx / (8 * nN), rem = idx - grp * 8 * nN;
  tm = grp * 8 + (rem & 7); tn = rem >> 3; return true;
}

__device__ __forceinline__ void transpose_tile(const float* src, u16* dst, int K, int N, int kt, int nt, char* lds) {
  float* tile = (float*)lds;
  const int tid = ltid();
  __syncthreads();
#pragma unroll
  for (int i = 0; i < 4; ++i) {
    const int e = tid + 256 * i, r = e >> 4, c4 = (e & 15) * 4;
    const float4 v = ntld4(src + (long)(kt * 64 + r) * N + nt * 64 + c4);
    tile[r * 65 + c4] = v.x; tile[r * 65 + c4 + 1] = v.y; tile[r * 65 + c4 + 2] = v.z; tile[r * 65 + c4 + 3] = v.w;
  }
  __syncthreads();
#pragma unroll
  for (int i = 0; i < 2; ++i) {
    const int e = tid + 256 * i, n = e >> 3, k8 = (e & 7) * 8;
    u32x4 w;
    w.x = cvtpk(tile[(k8 + 0) * 65 + n], tile[(k8 + 1) * 65 + n]); w.y = cvtpk(tile[(k8 + 2) * 65 + n], tile[(k8 + 3) * 65 + n]);
    w.z = cvtpk(tile[(k8 + 4) * 65 + n], tile[(k8 + 5) * 65 + n]); w.w = cvtpk(tile[(k8 + 6) * 65 + n], tile[(k8 + 7) * 65 + n]);
    *(u32x4*)(dst + (long)(nt * 64 + n) * K + kt * 64 + k8) = w;
  }
}
__device__ __forceinline__ void phase0(const P& p, char* lds) {
  const int tid = ltid(), bid = blockIdx.x, nb = gridDim.x;
  for (int layer = 0; layer < 2; ++layer) {
    for (int m = 0; m < 7; ++m) {
      const float* src; u16* dst; int K, N;
      switch (m) {
        case 0: src = p.w_in + (size_t)layer * 1024 * 2816; dst = (u16*)(p.ws + OFF_WIN + layer * SZ_WIN); K = 1024; N = 2816; break;
        case 1: src = p.w_out + (size_t)layer * 1024 * 1024; dst = (u16*)(p.ws + OFF_WOUT + layer * SZ_WOUT); K = 1024; N = 1024; break;
        case 2: src = p.w_up + (size_t)layer * 1024 * 5632; dst = (u16*)(p.ws + OFF_WUP + layer * SZ_WUP); K = 1024; N = 5632; break;
        case 3: src = p.w_down + (size_t)layer * 2816 * 1024; dst = (u16*)(p.ws + OFF_WDN + layer * SZ_WDN); K = 2816; N = 1024; break;
        case 4: src = p.ple_w + (size_t)layer * 256 * 1024; dst = (u16*)(p.ws + OFF_WPLE + layer * SZ_WPLE); K = 256; N = 1024; break;
        case 5: src = p.gate_w + (size_t)layer * 1024 * 1024; dst = (u16*)(p.ws + OFF_WGATE + layer * SZ_WGATE); K = 1024; N = 1024; break;
        default: src = p.glu_w + (size_t)layer * 256 * 256; dst = (u16*)(p.ws + OFF_WGLU + layer * SZ_WGLU); K = 256; N = 256; break;
      }
      const int nkt = K / 64, nnt = N / 64;
      for (int t = bid; t < nkt * nnt; t += nb) transpose_tile(src, dst, K, N, t / nnt, t % nnt, lds);
    }
  }
  const long gt = (long)bid * NTHR + tid, gn = (long)nb * NTHR;
  { u16* xb = (u16*)(p.ws + OFF_XB);
    for (long i = gt; i < (long)TT * DM / 8; i += gn) {
      const float4* q = (const float4*)(p.x + i * 8); float4 a = ntld4(q), b = ntld4(q + 1);
      u32x4 w = {cvtpk(a.x, a.y), cvtpk(a.z, a.w), cvtpk(b.x, b.y), cvtpk(b.z, b.w)};
      *(u32x4*)(xb + i * 8) = w; } }
  { float* ct = (float*)(p.ws + OFF_COS); float* st = (float*)(p.ws + OFF_SIN);
    for (long i = gt; i < (long)TT * 32; i += gn) {
      const int t = (int)(i >> 5), j = (int)(i & 31);
      const float inv = powf(10000.f, -(float)(2 * j) / 64.f);
      const float ang = (float)p.pos[t] * inv;
      float s, c; sincosf(ang, &s, &c); ct[i] = c; st[i] = s; } }
  { float* pw = (float*)(p.ws + OFF_PW); float* bb = (float*)(p.ws + OFF_BB);
    for (long t = gt; t < (long)4096 * 33; t += gn) {
      const long i = t / 33; const int k = (int)(t - i * 33);
      const double are = p.A_re[i], aim = p.A_im[i], step = exp((double)p.log_dt[i >> 6]);
      const double mag = exp(k * step * are), ang = k * step * aim;
      pw[t * 2] = (float)(mag * cos(ang)); pw[t * 2 + 1] = (float)(mag * sin(ang));
    }
    for (long t = gt; t < (long)4096 * 16; t += gn) {
      const long i = t >> 4;
      const double are = p.A_re[i], aim = p.A_im[i], step = exp((double)p.log_dt[i >> 6]);
      const double e = exp(step * are), abr = e * cos(step * aim), abi = e * sin(step * aim);
      const double den = are * are + aim * aim, nr = abr - 1.0, ni = abi;
      const double cre = (nr * are + ni * aim) / den, cim = (ni * are - nr * aim) / den;
      const double br = p.B_re[t], bi = p.B_im[t];
      bb[t * 2] = (float)(cre * br - cim * bi); bb[t * 2 + 1] = (float)(cre * bi + cim * br);
    } }
  if (gt < 512) ((unsigned*)(p.ws + OFF_ZERO))[gt] = 0u;
  if (gt < 2) {
    const int l = (int)gt; float s1 = 0.f, s2 = 0.f;
    for (int j = 0; j < 64; ++j) { s1 += p.lq1[l * 64 + j] * p.lk1[l * 64 + j]; s2 += p.lq2[l * 64 + j] * p.lk2[l * 64 + j]; }
    const float linit = 0.8f - 0.6f * expf(-0.3f * (float)l);
    ((float*)(p.ws + OFF_LAM))[l] = expf(s1) - expf(s2) + linit;
    ((float*)(p.ws + OFF_LAM))[2 + l] = 1.f - linit;
  }
}

__device__ __forceinline__ void s5_build_ktab_F(const P& p) {
  const unsigned gt = blockIdx.x * NTHR + ltid(), gn = gridDim.x * NTHR;
  const float* pw = (const float*)(p.ws + OFF_PW); const float* bb = (const float*)(p.ws + OFF_BB);
  float* kt = (float*)(p.ws + OFF_KTAB);
  for (unsigned i = gt; i < 2u * 16 * 2 * 32 * 256; i += gn) {
    const int ci = (int)(i & 15), co = (int)((i >> 4) & 15), lag = (int)((i >> 8) & 31), dir = (int)((i >> 13) & 1), g = (int)((i >> 14) & 15), l = (int)(i >> 18);
    const long ldg = ((long)(l * 2 + dir) * 16 + g);
    const float* cre = p.C_re + (ldg * 16 + co) * 64; const float* cim = p.C_im + (ldg * 16 + co) * 64;
    float s = 0.f;
    for (int q = 0; q < 64; ++q) {
      const long lp = ldg * 64 + q;
      const float pr = pw[(lp * 33 + lag) * 2], pi = pw[(lp * 33 + lag) * 2 + 1];
      const float br = bb[(lp * 16 + ci) * 2], bi = bb[(lp * 16 + ci) * 2 + 1];
      const float wre = pr * br - pi * bi, wim = pr * bi + pi * br;
      s += cre[q] * wre - cim[q] * wim;
    }
    kt[i] = s;
  }
  for (unsigned i = gt; i < 2u * 16 * 256 * 512; i += gn) {
    const int kk = (int)(i & 511), n = (int)((i >> 9) & 255), g = (int)((i >> 17) & 15), l = (int)(i >> 21);
    const int dir = n >> 7, isim = (n >> 6) & 1, q = n & 63, j = kk >> 4, ci = kk & 15;
    const long lp = (((long)(l * 2 + dir) * 16 + g) * 64 + q);
    const int pwk = dir ? j : 31 - j;
    const float pr = pw[(lp * 33 + pwk) * 2], pi = pw[(lp * 33 + pwk) * 2 + 1];
    const float br = bb[(lp * 16 + ci) * 2], bi = bb[(lp * 16 + ci) * 2 + 1];
    const float v = isim ? (pr * bi + pi * br) : (pr * br - pi * bi);
    ((u16*)(p.ws + OFF_S5F))[i] = f2bf(v);
  }
}
__device__ __forceinline__ void s5_build_M(const P& p) {
  const unsigned gt = blockIdx.x * NTHR + ltid(), gn = gridDim.x * NTHR;
  const float* pw = (const float*)(p.ws + OFF_PW); const float* kt = (const float*)(p.ws + OFF_KTAB);
  for (unsigned i = gt; i < 2u * 16 * 512 * 768; i += gn) {
    const unsigned r = i / 768u; const int kk = (int)(i - r * 768u); const int n = (int)(r & 511), g = (int)((r >> 9) & 15), l = (int)(r >> 13);
    const int ii = n >> 4, co = n & 15;
    float v;
    if (kk < 512) {
      const int j = kk >> 4, ci = kk & 15;
      const float* k0 = kt + ((long)(l * 16 + g) * 2 + 0) * 32 * 256; const float* k1 = k0 + 32 * 256;
      if (ii > j) v = k0[(ii - j) * 256 + co * 16 + ci];
      else if (ii < j) v = k1[(j - ii) * 256 + co * 16 + ci];
      else v = k0[co * 16 + ci] + k1[co * 16 + ci] + (co == ci ? p.Dp[l * 256 + g * 16 + co] : 0.f);
    } else {
      const int qq = kk - 512, dir = qq >> 7, isim = (qq >> 6) & 1, q = qq & 63;
      const long ldg = ((long)(l * 2 + dir) * 16 + g);
      const int pwk = dir ? 32 - ii : ii + 1;
      const float pr = pw[((ldg * 64 + q) * 33 + pwk) * 2], pi = pw[((ldg * 64 + q) * 33 + pwk) * 2 + 1];
      const float cr = p.C_re[(ldg * 16 + co) * 64 + q], cim = p.C_im[(ldg * 16 + co) * 64 + q];
      v = isim ? -(cr * pi + cim * pr) : (cr * pr - cim * pi);
    }
    ((u16*)(p.ws + OFF_S5M))[i] = f2bf(v);
  }
}

__device__ __forceinline__ void phase_z(const P& p, int layer, char* lds) {
  const u16* xb = (const u16*)(p.ws + OFF_XB); const u16* wt = (const u16*)(p.ws + OFF_WIN + layer * SZ_WIN);
  u16* z = (u16*)(p.ws + OFF_Z);
  const float* ct = (const float*)(p.ws + OFF_COS); const float* st = (const float*)(p.ws + OFF_SIN);
  const int lane = ltid() & 63, wid = ltid() >> 6, wr = wid >> 1, wc = wid & 1, r32 = lane & 31, hi = lane >> 5;
  int tm, tn;
  for (int it = 0; tile_at(it, 256, 22, tm, tn); ++it) {
    f32x16 acc[2][2] = {};
    LdBf al{xb + (long)tm * 128 * DM, DM}, bl{wt + (long)tn * 128 * DM, DM};
    gemm_plain(acc, al, bl, DM, lds);
    const int span = tn * 2 + wc, colb = span * 64;
    const bool rope = (span < 16) || (span >= 24 && span < 32);
    const float sc = (span < 8 || (span >= 28 && span < 32)) ? 0.125f : 1.f;
    const unsigned rb = (unsigned)(tm * 128 + wr * 64 + 4 * hi + opq());
    if (rope) {
#pragma unroll
      for (int mi = 0; mi < 2; ++mi) {
        float cc[16], ss[16];
#pragma unroll
        for (int r = 0; r < 16; ++r) { const unsigned row = rb + mi * 32 + (r & 3) + 8 * (r >> 2); cc[r] = ct[row * 32 + r32]; ss[r] = st[row * 32 + r32]; }
#pragma unroll
        for (int r = 0; r < 16; ++r) {
          const unsigned row = rb + mi * 32 + (r & 3) + 8 * (r >> 2);
          const float x1 = acc[mi][0][r], x2 = acc[mi][1][r];
          const unsigned w = cvtpk((x1 * cc[r] - x2 * ss[r]) * sc, (x2 * cc[r] + x1 * ss[r]) * sc);
          z[row * ZC + colb + r32] = (u16)w; z[row * ZC + colb + 32 + r32] = (u16)(w >> 16);
        }
        SBAR();
      }
    } else {
#pragma unroll
      for (int mi = 0; mi < 2; ++mi) {
#pragma unroll
        for (int r = 0; r < 16; ++r) {
          const unsigned row = rb + mi * 32 + (r & 3) + 8 * (r >> 2);
          const unsigned w = cvtpk(acc[mi][0][r] * sc, acc[mi][1][r] * sc);
          z[row * ZC + colb + r32] = (u16)w; z[row * ZC + colb + 32 + r32] = (u16)(w >> 16);
        }
        SBAR();
      }
    }
  }
}

__device__ __forceinline__ float ret_log2gamma(int h) { return log2f(1.f - exp2f(-5.f - (float)h)); }
__device__ __forceinline__ void ret_kv_item(const P& p, int item, char* lds) {
  const int tid = ltid(), lane = tid & 63, wid = tid >> 6, r32 = lane & 31, hi = lane >> 5;
  const int c = item & 63, h = (item >> 6) & 3, b = item >> 8;
  const u16* z = (const u16*)(p.ws + OFF_Z);
  const long tok0 = (long)b * SEQ + c * 128;
  u16* VT = (u16*)lds; u16* KF = VT + 64 * 136; u16* KB = KF + 64 * 136;
  const float lg = ret_log2gamma(h);
  { const int j = tid & 127, m = tid >> 7;
    const u16* kp = z + (tok0 + j) * ZC + C_DAK + h * 128 + m * 64;
    float ss = 0.f;
#pragma unroll
    for (int q8 = 0; q8 < 8; ++q8) { const bf16x8 kv = *(const bf16x8*)(kp + q8 * 8);
#pragma unroll
      for (int q = 0; q < 8; ++q) { const float f = bf2f((u16)kv[q]); ss += f * f; } }
#pragma unroll
    for (int o = 32; o >= 1; o >>= 1) ss = fmaxf(ss, __shfl_xor(ss, o));
    if (lane == 0) ((float*)(p.ws + OFF_KMX))[(((b * 4 + h) * 2 + m) * 64 + c) * 2 + (wid & 1)] = ss; }
  __syncthreads();
  for (int e = tid; e < 128 * 8; e += NTHR) {
    const int j = e >> 3, c8 = (e & 7) * 8;
    const bf16x8 kv = *(const bf16x8*)(z + (tok0 + j) * ZC + C_RK + h * 64 + c8);
    const bf16x8 vv = *(const bf16x8*)(z + (tok0 + j) * ZC + C_RV + h * 64 + c8);
    const float df = exp2f(lg * (float)(127 - j)), db = exp2f(lg * (float)j);
#pragma unroll
    for (int q = 0; q < 8; ++q) {
      const float kf = bf2f((u16)kv[q]);
      KF[(c8 + q) * 136 + j] = f2bf(kf * df); KB[(c8 + q) * 136 + j] = f2bf(kf * db); VT[(c8 + q) * 136 + j] = (u16)vv[q];
    }
  }
  __syncthreads();
  const int dir = wid >> 1, vb = wid & 1;
  const u16* KT = dir ? KB : KF;
  f32x16 a0 = {}, a1 = {};
#pragma unroll
  for (int ks = 0; ks < 8; ++ks) {
    const int ko = ks * 16 + hi * 8;
    const bf16x8 av = *(const bf16x8*)&VT[(vb * 32 + r32) * 136 + ko];
    const bf16x8 b0 = *(const bf16x8*)&KT[(r32) * 136 + ko];
    const bf16x8 b1 = *(const bf16x8*)&KT[(32 + r32) * 136 + ko];
    a0 = MFMA(av, b0, a0); a1 = MFMA(av, b1, a1);
  }
  float* kvt = (float*)(p.ws + OFF_KVT) + ((long)((b * 4 + h) * 64 + c) * 2 + dir) * 4096;
#pragma unroll
  for (int r = 0; r < 16; ++r) { const int v = vb * 32 + crow(r, hi); kvt[v * 64 + r32] = a0[r]; kvt[v * 64 + 32 + r32] = a1[r]; }
}
__device__ __forceinline__ void ret_scan(const P& p) {
  const long gt = (long)blockIdx.x * NTHR + ltid(), gn = (long)gridDim.x * NTHR;
  const float* kvt = (const float*)(p.ws + OFF_KVT); u16* kvs = (u16*)(p.ws + OFF_KVS);
  for (long i = gt; i < 16 * 2 * 4096; i += gn) {
    const int e = (int)(i & 4095), dir = (int)((i >> 12) & 1), bh = (int)(i >> 13), h = bh & 3;
    const float cd = exp2f(ret_log2gamma(h) * 128.f);
    float s = 0.f;
    const long base = ((long)(bh * 64) * 2 + dir) * 4096 + e;
    float v[64];
#pragma unroll
    for (int cc = 0; cc < 64; ++cc) v[cc] = kvt[base + (long)(dir ? 63 - cc : cc) * 8192];
#pragma unroll
    for (int cc = 0; cc < 64; ++cc) { kvs[base + (long)(dir ? 63 - cc : cc) * 8192] = f2bf(s); s = cd * s + v[cc]; }
  }
}
__device__ __forceinline__ void ret_out_item(const P& p, int layer, int item, char* lds) {
  const int tid = ltid(), lane = tid & 63, wid = tid >> 6, r32 = lane & 31, hi = lane >> 5;
  const int c = item & 63, h = (item >> 6) & 3, b = item >> 8;
  const u16* z = (const u16*)(p.ws + OFF_Z);
  const long tok0 = (long)b * SEQ + c * 128;
  u16* Qs = (u16*)lds; u16* Ks = Qs + 128 * 72; u16* VT = Ks + 128 * 72; u16* SF = VT + 64 * 136; u16* SB = SF + 64 * 72;
  const float lg = ret_log2gamma(h);
  __syncthreads();
  for (int e = tid; e < 128 * 8; e += NTHR) {
    const int j = e >> 3, c8 = (e & 7) * 8;
    *(bf16x8*)&Qs[j * 72 + c8] = *(const bf16x8*)(z + (tok0 + j) * ZC + C_RQ + h * 64 + c8);
    *(bf16x8*)&Ks[j * 72 + c8] = *(const bf16x8*)(z + (tok0 + j) * ZC + C_RK + h * 64 + c8);
    const bf16x8 vv = *(const bf16x8*)(z + (tok0 + j) * ZC + C_RV + h * 64 + c8);
#pragma unroll
    for (int q = 0; q < 8; ++q) VT[(c8 + q) * 136 + j] = (u16)vv[q];
  }
  { const u16* kvs = (const u16*)(p.ws + OFF_KVS) + ((long)((b * 4 + h) * 64 + c) * 2) * 4096;
    for (int e = tid; e < 2 * 64 * 8; e += NTHR) {
      const int dir = e >> 9, v = (e >> 3) & 63, c8 = (e & 7) * 8;
      *(bf16x8*)&((dir ? SB : SF)[v * 72 + c8]) = *(const bf16x8*)(kvs + (long)dir * 4096 + v * 64 + c8);
    } }
  __syncthreads();
  const int il = wid * 32 + r32;
  bf16x8 qf[4];
#pragma unroll
  for (int d0 = 0; d0 < 4; ++d0) qf[d0] = *(const bf16x8*)&Qs[il * 72 + d0 * 16 + hi * 8];
  bf16x8 pa[8];
#pragma unroll
  for (int jb = 0; jb < 4; ++jb) {
    f32x16 s = {};
#pragma unroll
    for (int d0 = 0; d0 < 4; ++d0) { const bf16x8 kf = *(const bf16x8*)&Ks[(jb * 32 + r32) * 72 + d0 * 16 + hi * 8]; s = MFMA(kf, qf[d0], s); }
#pragma unroll
    for (int r = 0; r < 16; ++r) { const int j = jb * 32 + crow(r, hi); const int dd = il > j ? il - j : j - il; s[r] *= exp2f(lg * (float)dd); }
#define PK4(PV, BASE, OUT) do { unsigned a0_ = cvtpk(PV[BASE + 0], PV[BASE + 1]), a1_ = cvtpk(PV[BASE + 2], PV[BASE + 3]);   \
    unsigned b0_ = cvtpk(PV[BASE + 4], PV[BASE + 5]), b1_ = cvtpk(PV[BASE + 6], PV[BASE + 7]);                              \
    auto r0_ = __builtin_amdgcn_permlane32_swap(a0_, b0_, false, false); auto r1_ = __builtin_amdgcn_permlane32_swap(a1_, b1_, false, false); \
    u32x4 w_ = {r0_[0], r1_[0], r0_[1], r1_[1]}; OUT = *reinterpret_cast<bf16x8*>(&w_); } while (0)
    PK4(s, 0, pa[2 * jb]); PK4(s, 8, pa[2 * jb + 1]);
  }
  f32x16 in0 = {}, in1 = {}, cf0 = {}, cf1 = {}, cb0 = {}, cb1 = {};
#pragma unroll
  for (int ks = 0; ks < 8; ++ks) {
    const bf16x8 v0 = *(const bf16x8*)&VT[(r32) * 136 + ks * 16 + hi * 8];
    const bf16x8 v1 = *(const bf16x8*)&VT[(32 + r32) * 136 + ks * 16 + hi * 8];
    in0 = MFMA(pa[ks], v0, in0); in1 = MFMA(pa[ks], v1, in1);
  }
#pragma unroll
  for (int d0 = 0; d0 < 4; ++d0) {
    const int ko = d0 * 16 + hi * 8;
    const bf16x8 f0 = *(const bf16x8*)&SF[(r32) * 72 + ko], f1 = *(const bf16x8*)&SF[(32 + r32) * 72 + ko];
    const bf16x8 g0 = *(const bf16x8*)&SB[(r32) * 72 + ko], g1 = *(const bf16x8*)&SB[(32 + r32) * 72 + ko];
    cf0 = MFMA(qf[d0], f0, cf0); cf1 = MFMA(qf[d0], f1, cf1); cb0 = MFMA(qf[d0], g0, cb0); cb1 = MFMA(qf[d0], g1, cb1);
  }
  const float gg0 = p.gn_g[layer * 64 + r32], gg1 = p.gn_g[layer * 64 + 32 + r32], gb0 = p.gn_b[layer * 64 + r32], gb1 = p.gn_b[layer * 64 + 32 + r32];
  u16* ymix = (u16*)(p.ws + OFF_YMIX);
  const int ib = wid * 32 + 4 * hi + opq();
  u16 gv0[16], gv1[16];
#pragma unroll
  for (int r = 0; r < 16; ++r) { const unsigned row = (unsigned)tok0 + ib + (r & 3) + 8 * (r >> 2);
    gv0[r] = z[row * ZC + C_RG + h * 64 + r32]; gv1[r] = z[row * ZC + C_RG + h * 64 + 32 + r32]; }
#pragma unroll
  for (int r = 0; r < 16; ++r) {
    const int i = ib + (r & 3) + 8 * (r >> 2);
    const float qd_f = exp2f(lg * (float)(i + 1)), qd_b = exp2f(lg * (float)(128 - i));
    const float o0 = in0[r] + qd_f * cf0[r] + qd_b * cb0[r], o1 = in1[r] + qd_f * cf1[r] + qd_b * cb1[r];
    const float mu = half_sum32(o0 + o1) * (1.f / 64.f);
    const float e0 = o0 - mu, e1 = o1 - mu;
    const float var = half_sum32(e0 * e0 + e1 * e1) * (1.f / 64.f);
    const float rs = rsqrtf(var + 1e-5f);
    const unsigned row = (unsigned)tok0 + i;
    const float g0 = bf2f(gv0[r]), g1 = bf2f(gv1[r]);
    ymix[row * 1024 + 512 + h * 64 + r32] = f2bf(g0 * sigmoidf_(g0) * (e0 * rs * gg0 + gb0));
    ymix[row * 1024 + 512 + h * 64 + 32 + r32] = f2bf(g1 * sigmoidf_(g1) * (e1 * rs * gg1 + gb1));
  }
}

__device__ __forceinline__ void s5_state_tile(const P& p, int layer, int t, char* lds) {
  const int g = t >> 4, tm = (t >> 1) & 7, tn = t & 1;
  const int lane = ltid() & 63, wid = ltid() >> 6, wr = wid >> 1, wc = wid & 1, r32 = lane & 31, hi = lane >> 5;
  f32x16 acc[2][2] = {};
  LdS5 al{(const u16*)(p.ws + OFF_Z), nullptr, g, tm * 128};
  LdBf bl{(const u16*)(p.ws + OFF_S5F + layer * SZ_S5F) + ((long)g * 256 + tn * 128) * 512, 512};
  gemm_plain(acc, al, bl, 512, lds);
  float* xe = (float*)(p.ws + OFF_XEND);
  const unsigned cb = (unsigned)(tm * 128 + wr * 64 + 4 * hi + opq());
#pragma unroll
  for (int mi = 0; mi < 2; ++mi) {
#pragma unroll
    for (int ni = 0; ni < 2; ++ni)
#pragma unroll
      for (int r = 0; r < 16; ++r) {
        const unsigned chunk = cb + mi * 32 + (r & 3) + 8 * (r >> 2); const unsigned n = tn * 128 + wc * 64 + ni * 32 + r32;
        xe[(chunk * 16 + g) * 256 + n] = acc[mi][ni][r];
      }
    SBAR();
  }
}
__device__ __forceinline__ void s5_scan(const P& p, int layer) {
  const long gt = (long)blockIdx.x * NTHR + ltid();
  if (gt >= 4 * 16 * 2 * 64) return;
  const int q = (int)(gt & 63), dir = (int)((gt >> 6) & 1), g = (int)((gt >> 7) & 15), b = (int)(gt >> 11);
  const float* pw = (const float*)(p.ws + OFF_PW);
  const long lp = (((long)(layer * 2 + dir) * 16 + g) * 64 + q);
  const float ar = pw[(lp * 33 + 32) * 2], ai = pw[(lp * 33 + 32) * 2 + 1];
  const float* xe = (const float*)(p.ws + OFF_XEND); u16* ss = (u16*)(p.ws + OFF_SINS);
  float sr = 0.f, si = 0.f;
  const long base = ((long)(b * 256) * 16 + g) * 256 + dir * 128 + q;
  for (int c0 = 0; c0 < 256; c0 += 32) {
    float xr[32], xi[32];
#pragma unroll
    for (int k = 0; k < 32; ++k) { const long off = base + (long)(dir ? 255 - (c0 + k) : c0 + k) * 4096; xr[k] = xe[off]; xi[k] = xe[off + 64]; }
#pragma unroll
    for (int k = 0; k < 32; ++k) {
      const long off = base + (long)(dir ? 255 - (c0 + k) : c0 + k) * 4096;
      ss[off] = f2bf(sr); ss[off + 64] = f2bf(si);
      const float nr = ar * sr - ai * si + xr[k], ni = ar * si + ai * sr + xi[k];
      sr = nr; si = ni;
    }
  }
}
__device__ __forceinline__ void s5_out_tile(const P& p, int layer, int t, char* lds) {
  const int g = t >> 5, tm = (t >> 2) & 7, tn = t & 3;
  const int lane = ltid() & 63, wid = ltid() >> 6, wr = wid >> 1, wc = wid & 1, r32 = lane & 31, hi = lane >> 5;
  f32x16 acc[2][2] = {};
  LdS5 al{(const u16*)(p.ws + OFF_Z), (const u16*)(p.ws + OFF_SINS), g, tm * 128};
  LdBf bl{(const u16*)(p.ws + OFF_S5M + layer * SZ_S5M) + ((long)g * 512 + tn * 128) * 768, 768};
  gemm_plain(acc, al, bl, 768, lds);
  u16* yg = (u16*)(p.ws + OFF_YGB);
  const unsigned cb = (unsigned)(tm * 128 + wr * 64 + 4 * hi + opq());
#pragma unroll
  for (int mi = 0; mi < 2; ++mi) {
#pragma unroll
    for (int ni = 0; ni < 2; ++ni)
#pragma unroll
      for (int r = 0; r < 16; ++r) {
        const unsigned chunk = cb + mi * 32 + (r & 3) + 8 * (r >> 2); const unsigned n = tn * 128 + wc * 64 + ni * 32 + r32;
        yg[(chunk * 32 + (n >> 4)) * 256 + g * 16 + (n & 15)] = f2bf(gelu_t(acc[mi][ni][r]));
      }
    SBAR();
  }
}
__device__ __forceinline__ void phase_glu(const P& p, int layer, char* lds) {
  const u16* yg = (const u16*)(p.ws + OFF_YGB); const u16* wt = (const u16*)(p.ws + OFF_WGLU + layer * SZ_WGLU);
  u16* ymix = (u16*)(p.ws + OFF_YMIX);
  const int lane = ltid() & 63, wid = ltid() >> 6, wr = wid >> 1, wc = wid & 1, r32 = lane & 31, hi = lane >> 5;
  int tm, tn;
  for (int it = 0; tile_at(it, 256, 2, tm, tn); ++it) {
    f32x16 acc[2][2] = {};
    LdBf al{yg + (long)tm * 128 * 256, 256}, bl{wt + (long)tn * 128 * 256, 256};
    gemm_plain(acc, al, bl, 256, lds);
    const unsigned rb = (unsigned)(tm * 128 + wr * 64 + 4 * hi + opq());
#pragma unroll
    for (int mi = 0; mi < 2; ++mi) {
#pragma unroll
      for (int ni = 0; ni < 2; ++ni) {
        const unsigned col = tn * 128 + wc * 64 + ni * 32 + r32;
        const float gb = p.glu_b[layer * 256 + col];
        u16 yv[16];
#pragma unroll
        for (int r = 0; r < 16; ++r) yv[r] = yg[(rb + mi * 32 + (r & 3) + 8 * (r >> 2)) * 256 + col];
#pragma unroll
        for (int r = 0; r < 16; ++r) {
          const unsigned row = rb + mi * 32 + (r & 3) + 8 * (r >> 2);
          ymix[row * 1024 + 768 + col] = f2bf(bf2f(yv[r]) * sigmoidf_(acc[mi][ni][r] + gb));
        }
      }
      SBAR();
    }
  }
}

constexpr float ATHR = 8.f;
__device__ __forceinline__ void partialSM(f32x16& p0, f32x16& p1, float& m_reg, float& mn, float& alpha) {
  constexpr float C = 1.4426950408889634f;
  float pmax = p0[0];
#pragma unroll
  for (int r = 1; r < 16; ++r) pmax = fmaxf(pmax, p0[r]);
#pragma unroll
  for (int r = 0; r < 16; ++r) pmax = fmaxf(pmax, p1[r]);
  { auto rr = __builtin_amdgcn_permlane32_swap(__float_as_uint(pmax), __float_as_uint(pmax), false, false);
    pmax = fmaxf(__uint_as_float(rr[0]), __uint_as_float(rr[1])); }
  if (__builtin_expect(__all(pmax - m_reg <= ATHR), 1)) { mn = m_reg; alpha = 1.f; }
  else { mn = fmaxf(m_reg, pmax); alpha = __builtin_amdgcn_exp2f((m_reg - mn) * C); m_reg = mn; }
  const float mnC = -mn * C;
#pragma unroll
  for (int r = 0; r < 16; ++r) p0[r] = __builtin_amdgcn_exp2f(fmaf(p0[r], C, mnC));
#pragma unroll
  for (int r = 0; r < 16; ++r) p1[r] = __builtin_amdgcn_exp2f(fmaf(p1[r], C, mnC));
}
__device__ __forceinline__ void finishSM(f32x16& p0, f32x16& p1, float alpha, float& l_reg, bf16x8& pa0, bf16x8& pa1, bf16x8& pa2, bf16x8& pa3) {
  float ps = 0;
#pragma unroll
  for (int r = 0; r < 16; ++r) ps += p0[r];
#pragma unroll
  for (int r = 0; r < 16; ++r) ps += p1[r];
  { auto rr = __builtin_amdgcn_permlane32_swap(__float_as_uint(ps), __float_as_uint(ps), false, false);
    ps = __uint_as_float(rr[0]) + __uint_as_float(rr[1]); }
  l_reg = l_reg * alpha + ps;
  PK4(p0, 0, pa0); PK4(p0, 8, pa1); PK4(p1, 0, pa2); PK4(p1, 8, pa3);
}
__device__ __forceinline__ int v_st(int k, int c) { const int kk = (k & ~0xC) | ((k & 4) << 1) | ((k & 8) >> 1); return ((kk >> 3) * 4 + (c >> 5)) * 512 + ((kk & 7) * 32 + (c & 31)) * 2; }
__device__ __forceinline__ int v_rd_base(int lane) { return ((lane & 3) << 3) | (((lane >> 2) & 3) << 6) | (((lane >> 4) & 1) << 5) | (((lane >> 5) & 1) << 8); }
constexpr int v_rd_off(int d0, int ks, int half) { return d0 * 512 + ks * 4096 + half * 2048; }
template <int OFF> __device__ __forceinline__ s16x4 tr_read(int vb) {
  s16x4 r; asm volatile("ds_read_b64_tr_b16 %0, %1 offset:%2" : "=&v"(r) : "v"(vb), "i"(OFF) : "memory"); return r;
}
template <int D0> __device__ __forceinline__ void pv_one(f32x16& od, int vb, bf16x8 pa0, bf16x8 pa1, bf16x8 pa2, bf16x8 pa3) {
#define PKV(L, H) (bf16x8){L[0], L[1], L[2], L[3], H[0], H[1], H[2], H[3]}
  { const s16x4 l0 = tr_read<v_rd_off(D0, 0, 0)>(vb), h0 = tr_read<v_rd_off(D0, 0, 1)>(vb), l1 = tr_read<v_rd_off(D0, 1, 0)>(vb), h1 = tr_read<v_rd_off(D0, 1, 1)>(vb);
    asm volatile("s_waitcnt lgkmcnt(0)" ::: "memory"); SBAR();
    od = MFMA(pa0, PKV(l0, h0), od); od = MFMA(pa1, PKV(l1, h1), od); }
  { const s16x4 l2 = tr_read<v_rd_off(D0, 2, 0)>(vb), h2 = tr_read<v_rd_off(D0, 2, 1)>(vb), l3 = tr_read<v_rd_off(D0, 3, 0)>(vb), h3 = tr_read<v_rd_off(D0, 3, 1)>(vb);
    asm volatile("s_waitcnt lgkmcnt(0)" ::: "memory"); SBAR();
    od = MFMA(pa2, PKV(l2, h2), od); od = MFMA(pa3, PKV(l3, h3), od); }
#undef PKV
}
template <int D0> __device__ __forceinline__ void pv_two(f32x16& oa, f32x16& ob, int vb, bf16x8 a0, bf16x8 a1, bf16x8 a2, bf16x8 a3,
                                                         bf16x8 b0, bf16x8 b1, bf16x8 b2, bf16x8 b3) {
#define PKV(L, H) (bf16x8){L[0], L[1], L[2], L[3], H[0], H[1], H[2], H[3]}
  { const s16x4 l0 = tr_read<v_rd_off(D0, 0, 0)>(vb), h0 = tr_read<v_rd_off(D0, 0, 1)>(vb), l1 = tr_read<v_rd_off(D0, 1, 0)>(vb), h1 = tr_read<v_rd_off(D0, 1, 1)>(vb);
    asm volatile("s_waitcnt lgkmcnt(0)" ::: "memory"); SBAR();
    const bf16x8 v0 = PKV(l0, h0), v1 = PKV(l1, h1);
    oa = MFMA(a0, v0, oa); ob = MFMA(b0, v0, ob); oa = MFMA(a1, v1, oa); ob = MFMA(b1, v1, ob); }
  { const s16x4 l2 = tr_read<v_rd_off(D0, 2, 0)>(vb), h2 = tr_read<v_rd_off(D0, 2, 1)>(vb), l3 = tr_read<v_rd_off(D0, 3, 0)>(vb), h3 = tr_read<v_rd_off(D0, 3, 1)>(vb);
    asm volatile("s_waitcnt lgkmcnt(0)" ::: "memory"); SBAR();
    const bf16x8 v2 = PKV(l2, h2), v3 = PKV(l3, h3);
    oa = MFMA(a2, v2, oa); ob = MFMA(b2, v2, ob); oa = MFMA(a3, v3, oa); ob = MFMA(b3, v3, ob); }
#undef PKV
}
constexpr int ATT_KB = 8192, ATT_VB = 16384, NTILE = SEQ / 64;
__device__ __forceinline__ void att_qkt(f32x16& p0, f32x16& p1, const char* Kb, const bf16x8 (&qr)[4], int koff, int ksw, int hi) {
  p0 = f32x16{}; p1 = f32x16{};
#pragma unroll
  for (int d0 = 0; d0 < 4; ++d0) {
    const int co = ((d0 * 2 + hi) ^ ksw) << 4;
    const bf16x8 b0 = *(const bf16x8*)(Kb + koff + co);
    const bf16x8 b1 = *(const bf16x8*)(Kb + koff + 4096 + co);
    p0 = MFMA(b0, qr[d0], p0); p1 = MFMA(b1, qr[d0], p1);
  }
}
__device__ __forceinline__ void sm_fixed(f32x16& p0, f32x16& p1, float mC, float& l_reg, bf16x8& pa0, bf16x8& pa1, bf16x8& pa2, bf16x8& pa3) {
  constexpr float C = 1.4426950408889634f;
#pragma unroll
  for (int r = 0; r < 16; ++r) p0[r] = __builtin_amdgcn_exp2f(fmaf(p0[r], C, -mC));
#pragma unroll
  for (int r = 0; r < 16; ++r) p1[r] = __builtin_amdgcn_exp2f(fmaf(p1[r], C, -mC));
  float ps = 0;
#pragma unroll
  for (int r = 0; r < 16; ++r) ps += p0[r];
#pragma unroll
  for (int r = 0; r < 16; ++r) ps += p1[r];
  { auto rr = __builtin_amdgcn_permlane32_swap(__float_as_uint(ps), __float_as_uint(ps), false, false);
    ps = __uint_as_float(rr[0]) + __uint_as_float(rr[1]); }
  l_reg += ps;
#define PK4N(PV, BASE, OUT) do { u32x4 w_ = {cvtpk(PV[BASE + 0], PV[BASE + 1]), cvtpk(PV[BASE + 2], PV[BASE + 3]), \
    cvtpk(PV[BASE + 4], PV[BASE + 5]), cvtpk(PV[BASE + 6], PV[BASE + 7])}; OUT = *reinterpret_cast<bf16x8*>(&w_); } while (0)
  PK4N(p0, 0, pa0); PK4N(p0, 8, pa1); PK4N(p1, 0, pa2); PK4N(p1, 8, pa3);
#undef PK4N
}
__device__ __forceinline__ float sumsq8(bf16x8 v) { float s = 0.f;
#pragma unroll
  for (int q = 0; q < 8; ++q) { const float f = bf2f((u16)v[q]); s += f * f; } return s; }
__device__ __forceinline__ void att_qkt_p(f32x16& p0, f32x16& p1, const char* Kb, const bf16x8 (&qr)[2], const char* Qp, int koff, int ksw, int hi) {
  p0 = f32x16{}; p1 = f32x16{};
#pragma unroll
  for (int d0 = 0; d0 < 4; ++d0) {
    const int co = ((d0 * 2 + hi) ^ ksw) << 4;
    const bf16x8 b0 = *(const bf16x8*)(Kb + koff + co);
    const bf16x8 b1 = *(const bf16x8*)(Kb + koff + 4096 + co);
    const bf16x8 qd = d0 < 2 ? qr[d0 & 1] : *(const bf16x8*)(Qp + (d0 - 2) * 4096);
    p0 = MFMA(b0, qd, p0); p1 = MFMA(b1, qd, p1);
  }
}
__device__ __forceinline__ void attn_item(const P& p, int layer, int item, char* lds) {
  const int tid = ltid(), wid = tid >> 6, lane = tid & 63, r32 = lane & 31, hi = lane >> 5;
  const int qb = item & 63, h = (item >> 6) & 3, b = item >> 8;
  const u16* z = (const u16*)(p.ws + OFF_Z);
  const long tokb = (long)b * SEQ, tokq = tokb + qb * 128;
  constexpr int STG = 2 * ATT_KB + ATT_VB;
  float* wsf = (float*)(lds + 2 * STG) + wid * 64;
  float* li_l = wsf; float* al_l = wsf + 32;
  const int vb0 = (int)(uintptr_t)(lds + 2 * ATT_KB) + v_rd_base(lane);
  const int koff = r32 * 128, ksw = (r32 >> 1) & 7;
  const unsigned k_src = (tid >> 3) * ZC + (((tid & 7) ^ ((tid >> 4) & 7)) << 3);
  const int v_kl = (tid & 31) >> 2;
  const unsigned v_src = (v_kl | ((tid >> 7) << 3)) * ZC + ((tid >> 5) & 3) * 32 + (tid & 3) * 8;
  char* lw = lds + tid * 16;
  const float lam = ((const float*)(p.ws + OFF_LAM))[layer];
  const u16* Kg = z + tokb * ZC + C_DAK + h * 128; const u16* Vg = z + tokb * ZC + C_DAV + h * 128;
  bf16x8 q1[4], q2[2];
  char* Qp = lds + 2 * STG + 1024 + tid * 16;
#pragma unroll
  for (int d0 = 0; d0 < 4; ++d0) q1[d0] = *(const bf16x8*)(z + (tokq + wid * 32 + r32) * ZC + h * 128 + d0 * 16 + hi * 8);
#pragma unroll
  for (int d0 = 0; d0 < 2; ++d0) q2[d0] = *(const bf16x8*)(z + (tokq + wid * 32 + r32) * ZC + h * 128 + 64 + d0 * 16 + hi * 8);
  __syncthreads();
  float qs1 = 0.f, qs2 = 0.f;
#pragma unroll
  for (int d0 = 0; d0 < 4; ++d0) qs1 += sumsq8(q1[d0]);
#pragma unroll
  for (int d0 = 0; d0 < 2; ++d0) qs2 += sumsq8(q2[d0]);
#pragma unroll
  for (int d0 = 2; d0 < 4; ++d0) { const bf16x8 t = *(const bf16x8*)(z + (tokq + wid * 32 + r32) * ZC + h * 128 + 64 + d0 * 16 + hi * 8);
    qs2 += sumsq8(t); *(bf16x8*)(Qp + (d0 - 2) * 4096) = t; }
  { auto rr = __builtin_amdgcn_permlane32_swap(__float_as_uint(qs1), __float_as_uint(qs1), false, false); qs1 = __uint_as_float(rr[0]) + __uint_as_float(rr[1]); }
  { auto rr = __builtin_amdgcn_permlane32_swap(__float_as_uint(qs2), __float_as_uint(qs2), false, false); qs2 = __uint_as_float(rr[0]) + __uint_as_float(rr[1]); }
  float mC1, mC2;
  { const float* kmx = (const float*)(p.ws + OFF_KMX) + (size_t)((b * 4 + h) * 2) * 128;
    float k1 = fmaxf(kmx[lane], kmx[64 + lane]), k2 = fmaxf(kmx[128 + lane], kmx[192 + lane]);
#pragma unroll
    for (int o = 32; o >= 1; o >>= 1) { k1 = fmaxf(k1, __shfl_xor(k1, o)); k2 = fmaxf(k2, __shfl_xor(k2, o)); }
    mC1 = sqrtf(qs1 * k1) * 1.4426950408889634f; mC2 = sqrtf(qs2 * k2) * 1.4426950408889634f; }
  float l1 = 0.f, l2 = 0.f;
  f32x16 o1[4], o2[4];
#pragma unroll
  for (int d = 0; d < 4; ++d) { o1[d] = f32x16{}; o2[d] = f32x16{}; }
#define ISSUE_T(t, sl) do { char* S_ = lw + (sl) * STG; \
    _Pragma("unroll") for (int i_ = 0; i_ < 2; ++i_) { glds16(Kg + (long)((t) * 64 + 32 * i_) * ZC + k_src, S_ + i_ * 4096); \
                                                        glds16(Kg + 64 + (long)((t) * 64 + 32 * i_) * ZC + k_src, S_ + ATT_KB + i_ * 4096); } \
    _Pragma("unroll") for (int i_ = 0; i_ < 4; ++i_) glds16(Vg + (long)((t) * 64 + 16 * i_) * ZC + v_src, S_ + 2 * ATT_KB + i_ * 4096); } while (0)
#define RESC(a, O) do { if (__any((a) < 1.f)) { if (hi == 0) al_l[r32] = (a); asm volatile("s_waitcnt lgkmcnt(0)" ::: "memory"); \
    _Pragma("unroll") for (int d_ = 0; d_ < 4; ++d_) _Pragma("unroll") for (int r_ = 0; r_ < 16; ++r_) O[d_][r_] *= al_l[crow(r_, hi)]; } } while (0)
#define MAPSTEP(QKT, MC, L, PA0, PA1, PA2, PA3) do { f32x16 p0, p1; \
    QKT; \
    sm_fixed(p0, p1, MC, L, PA0, PA1, PA2, PA3); } while (0)
  __syncthreads();
  ISSUE_T(0, 0);
  for (int j = 0; j < NTILE; ++j) {
    asm volatile("s_waitcnt vmcnt(0)" ::: "memory"); __syncthreads();
    if (j + 1 < NTILE) ISSUE_T(j + 1, (j + 1) & 1);
    const char* S = lds + (j & 1) * STG;
    const int vb = vb0 + (j & 1) * STG;
    bf16x8 pa0, pa1, pa2, pa3, pb0, pb1, pb2, pb3;
    MAPSTEP(att_qkt(p0, p1, S, q1, koff, ksw, hi), mC1, l1, pa0, pa1, pa2, pa3);
    SBAR();
    MAPSTEP(att_qkt_p(p0, p1, S + ATT_KB, q2, Qp, koff, ksw, hi), mC2, l2, pb0, pb1, pb2, pb3);
    SBAR();
    pv_two<0>(o1[0], o2[0], vb, pa0, pa1, pa2, pa3, pb0, pb1, pb2, pb3); pv_two<1>(o1[1], o2[1], vb, pa0, pa1, pa2, pa3, pb0, pb1, pb2, pb3);
    pv_two<2>(o1[2], o2[2], vb, pa0, pa1, pa2, pa3, pb0, pb1, pb2, pb3); pv_two<3>(o1[3], o2[3], vb, pa0, pa1, pa2, pa3, pb0, pb1, pb2, pb3);
  }
#undef MAPSTEP
#undef RESC
#undef ISSUE_T
  float r1[16], r2[16];
  if (hi == 0) li_l[r32] = l1;
  asm volatile("s_waitcnt lgkmcnt(0)" ::: "memory");
#pragma unroll
  for (int r = 0; r < 16; ++r) r1[r] = 1.f / li_l[crow(r, hi)];
  asm volatile("s_waitcnt lgkmcnt(0)" ::: "memory");
  if (hi == 0) li_l[r32] = l2;
  asm volatile("s_waitcnt lgkmcnt(0)" ::: "memory");
#pragma unroll
  for (int r = 0; r < 16; ++r) r2[r] = lam / li_l[crow(r, hi)];
  const int oz = opq();
  const float gsc = ((const float*)(p.ws + OFF_LAM))[2 + layer];
  float sg[4];
#pragma unroll
  for (int d = 0; d < 4; ++d) sg[d] = p.subln[layer * 128 + d * 32 + r32] * gsc;
  u16* ymix = (u16*)(p.ws + OFF_YMIX);
  const unsigned yb = (unsigned)(tokq + wid * 32 + 4 * hi + oz) * 1024 + h * 128 + r32;
#pragma unroll
  for (int r = 0; r < 16; ++r) {
    float v[4]; float ss = 0.f;
#pragma unroll
    for (int d = 0; d < 4; ++d) { v[d] = o1[d][r] * r1[r] - o2[d][r] * r2[r]; ss += v[d] * v[d]; }
    ss = half_sum32(ss);
    const float rs = rsqrtf(ss * (1.f / 128.f) + 1e-6f);
#pragma unroll
    for (int d = 0; d < 4; ++d) ymix[yb + (unsigned)((r & 3) + 8 * (r >> 2)) * 1024 + d * 32] = f2bf(v[d] * rs * sg[d]);
    if ((r & 3) == 3) SBAR();
  }
}

__device__ __forceinline__ void phase_wout(const P& p, int layer, char* lds) {
  const u16* ym = (const u16*)(p.ws + OFF_YMIX); const u16* wt = (const u16*)(p.ws + OFF_WOUT + layer * SZ_WOUT);
  const u16* xbr = (const u16*)(p.ws + OFF_XB);
  const int lane = ltid() & 63, wid = ltid() >> 6, wr = wid >> 1, wc = wid & 1, r32 = lane & 31, hi = lane >> 5;
  int tm, tn;
  for (int it = 0; tile_at(it, 256, 8, tm, tn); ++it) {
    f32x16 acc[2][2] = {};
    LdBf al{ym + (long)tm * 128 * 1024, 1024}, bl{wt + (long)tn * 128 * 1024, 1024};
    gemm_plain(acc, al, bl, 1024, lds);
    const unsigned rb = (unsigned)(tm * 128 + wr * 64 + 4 * hi + opq());
    _Float16* pre1 = (_Float16*)(p.ws + OFF_PRE1);
#pragma unroll
    for (int mi = 0; mi < 2; ++mi) {
      float xr[2][16];
      if (layer == 0) {
#pragma unroll
        for (int ni = 0; ni < 2; ++ni)
#pragma unroll
          for (int r = 0; r < 16; ++r) xr[ni][r] = p.x[(rb + mi * 32 + (r & 3) + 8 * (r >> 2)) * DM + tn * 128 + wc * 64 + ni * 32 + r32];
      } else {
#pragma unroll
        for (int ni = 0; ni < 2; ++ni)
#pragma unroll
          for (int r = 0; r < 16; ++r) xr[ni][r] = bf2f(xbr[(rb + mi * 32 + (r & 3) + 8 * (r >> 2)) * DM + tn * 128 + wc * 64 + ni * 32 + r32]);
      }
#pragma unroll
      for (int ni = 0; ni < 2; ++ni)
#pragma unroll
        for (int r = 0; r < 16; ++r) {
          const unsigned row = rb + mi * 32 + (r & 3) + 8 * (r >> 2); const unsigned col = tn * 128 + wc * 64 + ni * 32 + r32;
          pre1[row * DM + col] = (_Float16)(ALPHA * xr[ni][r] + acc[mi][ni][r]);
        }
      SBAR();
    }
  }
}
__device__ __forceinline__ float4 ldh4(const _Float16* q) {
  typedef _Float16 h4_ __attribute__((ext_vector_type(4)));
  const h4_ t = __builtin_nontemporal_load((const h4_*)q); return float4{(float)t[0], (float)t[1], (float)t[2], (float)t[3]};
}
__device__ __forceinline__ void phase_ln(const P& p, const float* g, const float* bta, const float* pconv, bool write_f32, const _Float16* pre) {
  const int lane = ltid() & 63, wid = ltid() >> 6;
  u16* xb = (u16*)(p.ws + OFF_XB);
  if (pconv) {
    u16* pb = (u16*)(p.ws + OFF_PB);
    for (long i = (long)blockIdx.x * NTHR + ltid(); i < (long)TT * 256 / 8; i += (long)gridDim.x * NTHR) {
      const float4* q = (const float4*)(pconv + i * 8); float4 a = ntld4(q), b = ntld4(q + 1);
      u32x4 w = {cvtpk(a.x, a.y), cvtpk(a.z, a.w), cvtpk(b.x, b.y), cvtpk(b.z, b.w)};
      *(u32x4*)(pb + i * 8) = w; }
  }
  const long rstride = (long)gridDim.x * 4;
  float4 gg4[4], bb4[4];
#pragma unroll
  for (int i = 0; i < 4; ++i) { gg4[i] = *(const float4*)(g + (i * 64 + lane) * 4); bb4[i] = *(const float4*)(bta + (i * 64 + lane) * 4); }
  typedef _Float16 h4p_ __attribute__((ext_vector_type(4)));
  h4p_ nx[2][4];
  { const long r0 = (long)blockIdx.x * 4 + wid, r1 = r0 + rstride;
#pragma unroll
    for (int i = 0; i < 4; ++i) { nx[0][i] = r0 < TT ? __builtin_nontemporal_load((const h4p_*)(pre + r0 * DM + (i * 64 + lane) * 4)) : h4p_{0, 0, 0, 0};
                                  nx[1][i] = r1 < TT ? __builtin_nontemporal_load((const h4p_*)(pre + r1 * DM + (i * 64 + lane) * 4)) : h4p_{0, 0, 0, 0}; } }
  for (long row0 = (long)blockIdx.x * 4 + wid; row0 < TT; row0 += 2 * rstride) {
    const long row1 = row0 + rstride; const bool two = row1 < TT;
    float4 v[2][4]; float s[2] = {0.f, 0.f};
#pragma unroll
    for (int u = 0; u < 2; ++u)
#pragma unroll
      for (int i = 0; i < 4; ++i) { v[u][i] = float4{(float)nx[u][i][0], (float)nx[u][i][1], (float)nx[u][i][2], (float)nx[u][i][3]};
        s[u] += v[u][i].x + v[u][i].y + v[u][i].z + v[u][i].w; }
    { const long n0 = row0 + 2 * rstride, n1 = n0 + rstride;
      if (n0 < TT) {
#pragma unroll
        for (int i = 0; i < 4; ++i) nx[0][i] = __builtin_nontemporal_load((const h4p_*)(pre + n0 * DM + (i * 64 + lane) * 4));
      }
      if (n1 < TT) {
#pragma unroll
        for (int i = 0; i < 4; ++i) nx[1][i] = __builtin_nontemporal_load((const h4p_*)(pre + n1 * DM + (i * 64 + lane) * 4));
      } }
#pragma unroll
    for (int u = 0; u < 2; ++u) {
      if (u == 1 && !two) break;
      const long row = u ? row1 : row0;
      const float mu = wave_sum(s[u]) * (1.f / 1024.f);
      float q = 0.f;
#pragma unroll
      for (int i = 0; i < 4; ++i) { v[u][i].x -= mu; v[u][i].y -= mu; v[u][i].z -= mu; v[u][i].w -= mu; q += v[u][i].x * v[u][i].x + v[u][i].y * v[u][i].y + v[u][i].z * v[u][i].z + v[u][i].w * v[u][i].w; }
      const float rs = rsqrtf(wave_sum(q) * (1.f / 1024.f) + 1e-5f);
#pragma unroll
      for (int i = 0; i < 4; ++i) {
        const int c = (i * 64 + lane) * 4;
        const float4 gg = gg4[i], bb = bb4[i];
        float4 y = {v[u][i].x * rs * gg.x + bb.x, v[u][i].y * rs * gg.y + bb.y, v[u][i].z * rs * gg.z + bb.z, v[u][i].w * rs * gg.w + bb.w};
        if (write_f32) *(float4*)(p.out + row * DM + c) = y;
        u32x2 w = {cvtpk(y.x, y.y), cvtpk(y.z, y.w)};
        *(u32x2*)(xb + row * DM + c) = w;
      }
    }
  }
}
__device__ __forceinline__ void phase_ffn_up(const P& p, int layer, char* lds) {
  const u16* xb = (const u16*)(p.ws + OFF_XB); const u16* wt = (const u16*)(p.ws + OFF_WUP + layer * SZ_WUP);
  u16* aout = (u16*)(p.ws + OFF_A);
  const int tid = ltid(), lane = tid & 63, wid = tid >> 6, wr = wid >> 1, wc = wid & 1, r32 = lane & 31, hi = lane >> 5;
  float* G = (float*)lds;
  int tm, tn;
  for (int it = 0; tile_at(it, 256, 44, tm, tn); ++it) {
    f32x16 acc[2][2] = {}; f32x16 hacc = {};
    const long r0 = (long)tm * 128;
    const bool top0 = (r0 % SEQ) == 0, bot0 = ((r0 + 128) % SEQ) == 0;
    LdBf al{xb + r0 * DM, DM}; LdBsplit bl{wt, DM, tn * 64};
    const u16* zr = (const u16*)(p.ws + OFF_ZERO);
    const u16* h0 = top0 ? zr : xb + (r0 - 1) * DM; const u16* h1 = bot0 ? zr : xb + (r0 + 128) * DM;
    gemm_core<true>(acc, hacc, al, bl, DM, lds, h0, h1, wc * 32, 64 + wc * 32);
    __syncthreads();
    const int lb0 = wr * 64 + 4 * hi + opq();
    float* Gc = G + wc * 32 + r32;
#pragma unroll
    for (int mi = 0; mi < 2; ++mi)
#pragma unroll
      for (int r = 0; r < 16; ++r) Gc[(1 + lb0 + mi * 32 + (r & 3) + 8 * (r >> 2)) * 65] = acc[mi][0][r];
    if (hi == 0) { if (wr == 0) Gc[0] = hacc[0]; else Gc[129 * 65] = hacc[1]; }
    __syncthreads();
    const int f = tn * 64 + wc * 32 + r32;
    const float w0 = p.conv_w[(layer * 3 + 0) * DFF + f], w1 = p.conv_w[(layer * 3 + 1) * DFF + f], w2 = p.conv_w[(layer * 3 + 2) * DFF + f];
    const float cb = p.conv_b[layer * DFF + f];
    const unsigned ob = (unsigned)(tm * 128) * DFF + f;
#pragma unroll
    for (int mi = 0; mi < 2; ++mi) {
      float gp[16], gn[16];
#pragma unroll
      for (int r = 0; r < 16; ++r) { const int lr = lb0 + mi * 32 + (r & 3) + 8 * (r >> 2); gp[r] = Gc[lr * 65]; gn[r] = Gc[(lr + 2) * 65]; }
#pragma unroll
      for (int r = 0; r < 16; r += 2) {
        const int lr = lb0 + mi * 32 + (r & 3) + 8 * (r >> 2);
        const float g0 = fmaf(w0, gp[r], fmaf(w1, acc[mi][0][r], fmaf(w2, gn[r], cb)));
        const float g1 = fmaf(w0, gp[r + 1], fmaf(w1, acc[mi][0][r + 1], fmaf(w2, gn[r + 1], cb)));
        const unsigned w = cvtpk(gelu_t(g0) * acc[mi][1][r], gelu_t(g1) * acc[mi][1][r + 1]);
        aout[ob + (unsigned)lr * DFF] = (u16)w; aout[ob + (unsigned)(lr + 1) * DFF] = (u16)(w >> 16);
      }
      SBAR();
    }
  }
}
__device__ __forceinline__ void phase_ffn_down(const P& p, int layer, char* lds) {
  const u16* xb = (const u16*)(p.ws + OFF_XB); const u16* ab = (const u16*)(p.ws + OFF_A);
  const u16* wd = (const u16*)(p.ws + OFF_WDN + layer * SZ_WDN); const u16* wg = (const u16*)(p.ws + OFF_WGATE + layer * SZ_WGATE);
  const u16* wp = (const u16*)(p.ws + OFF_WPLE + layer * SZ_WPLE);
  const u16* pb = (const u16*)(p.ws + OFF_PB);
  const int lane = ltid() & 63, wid = ltid() >> 6, wr = wid >> 1, wc = wid & 1, r32 = lane & 31, hi = lane >> 5;
  int tm, tn;
  for (int it = 0; tile_at(it, 256, 8, tm, tn); ++it) {
    f32x16 acc[2][2] = {};
    { LdBf al{xb + (long)tm * 128 * DM, DM}, bl{wg + (long)tn * 128 * DM, DM}; gemm_plain(acc, al, bl, DM, lds); }
#pragma unroll
    for (int mi = 0; mi < 2; ++mi)
#pragma unroll
      for (int ni = 0; ni < 2; ++ni)
#pragma unroll
        for (int r = 0; r < 16; ++r) acc[mi][ni][r] = sigmoidf_(acc[mi][ni][r]);
    f32x16 acc2[2][2] = {};
    { LdBf al{pb + (long)tm * 128 * 256, 256}; LdBf bl{wp + (long)tn * 128 * 256, 256}; gemm_plain(acc2, al, bl, 256, lds); }
#pragma unroll
    for (int mi = 0; mi < 2; ++mi)
#pragma unroll
      for (int ni = 0; ni < 2; ++ni) acc[mi][ni] = acc[mi][ni] * acc2[mi][ni];
    { LdBf al{ab + (long)tm * 128 * DFF, DFF}, bl{wd + (long)tn * 128 * DFF, DFF}; gemm_plain(acc, al, bl, DFF, lds); }
    const unsigned rb = (unsigned)(tm * 128 + wr * 64 + 4 * hi + opq());
#pragma unroll
    for (int mi = 0; mi < 2; ++mi) {
#pragma unroll
      for (int ni = 0; ni < 2; ++ni)
#pragma unroll
        for (int r = 0; r < 16; ++r) {
          const unsigned row = rb + mi * 32 + (r & 3) + 8 * (r >> 2); const unsigned col = tn * 128 + wc * 64 + ni * 32 + r32;
          ((_Float16*)(p.ws + OFF_PRE2))[row * DM + col] = (_Float16)(ALPHA * bf2f(xb[row * DM + col]) + acc[mi][ni][r]);
        }
      SBAR();
    }
  }
}

#define XB_TMO      128
#define XB_XCNT(j)  (256  + 64 * (j))
#define XB_XSUB(j)  (1280 + 64 * (j))
#define XB_XGEN(j)  (2304 + 64 * (j))
#define XB_TOP      3328
#define XB_TOPGEN   3392
#define XB_SPIN_CAP (1u << 20)
#define LAS __attribute__((address_space(3)))
__device__ __forceinline__ unsigned xb_ld(unsigned* p)              { return __hip_atomic_load(p, __ATOMIC_RELAXED, __HIP_MEMORY_SCOPE_AGENT); }
__device__ __forceinline__ unsigned xb_add(unsigned* p, unsigned v) { return __hip_atomic_fetch_add(p, v, __ATOMIC_RELAXED, __HIP_MEMORY_SCOPE_AGENT); }
__device__ __forceinline__ unsigned xb_xcc_id() { return (unsigned)__builtin_amdgcn_s_getreg((3 << 11) | 20) & 0xFu; }
#define XB_SPIN(cond, bar) do { unsigned _sp = 0; while (cond) { __builtin_amdgcn_s_sleep(1); \
    if ((++_sp & 255u) == 0u) { if (xb_ld(&(bar)[XB_TMO])) break; if (_sp > XB_SPIN_CAP) { atomicAdd(&(bar)[XB_TMO], 1u); break; } } } } while (0)
struct XcdBarrier { unsigned* bar; unsigned x; volatile LAS unsigned* st; };
__device__ __forceinline__ XcdBarrier xcd_barrier_post(unsigned* bar, volatile LAS unsigned* st) {
  XcdBarrier b; b.bar = bar; b.x = xb_xcc_id(); b.st = st;
  if (threadIdx.x == 0) (void)xb_add(&bar[XB_XCNT(b.x)], 1u);
  return b;
}
__device__ __forceinline__ void xcd_barrier_complete(unsigned* bar, unsigned x, unsigned& nloc, unsigned& nx) {
  const unsigned G = gridDim.x * gridDim.y * gridDim.z;
  unsigned sum, cnt, mine, sp = 0u;
  for (;;) {
    sum = 0u; cnt = 0u; mine = 0u;
#pragma unroll
    for (unsigned j = 0; j < 16; ++j) { const unsigned c = xb_ld(&bar[XB_XCNT(j)]); sum += c; cnt += (c > 0u) ? 1u : 0u; mine = (j == x) ? c : mine; }
    if (sum == G) break;
    __builtin_amdgcn_s_sleep(1);
    if ((++sp & 255u) == 0u) { if (xb_ld(&bar[XB_TMO])) break; if (sp > XB_SPIN_CAP) { atomicAdd(&bar[XB_TMO], 1u); break; } }
  }
  nloc = mine > 0u ? mine : 1u; nx = cnt > 0u ? cnt : 1u;
}
__device__ __forceinline__ void xcd_barrier(const XcdBarrier& b) {
  asm volatile("s_waitcnt vmcnt(0)" ::: "memory");
  __syncthreads();
  if (threadIdx.x == 0) {
    unsigned* bar = b.bar;
    __builtin_amdgcn_s_waitcnt(0);
    unsigned nloc = b.st[0], nx = b.st[1];
    if (nloc == 0u) { xcd_barrier_complete(bar, b.x, nloc, nx); b.st[0] = nloc; b.st[1] = nx; }
    const unsigned old = xb_add(&bar[XB_XSUB(b.x)], 1u);
    const unsigned gen = old / nloc;
    if (old + 1u == (gen + 1u) * nloc) {
      __builtin_amdgcn_fence(__ATOMIC_RELEASE, "agent");
      asm volatile("s_waitcnt vmcnt(0)" ::: "memory");
      const unsigned og = xb_add(&bar[XB_TOP], 1u);
      const unsigned tg = og / nx;
      if (og + 1u == (tg + 1u) * nx) xb_add(&bar[XB_TOPGEN], 1u);
      else XB_SPIN(xb_ld(&bar[XB_TOPGEN]) == tg, bar);
      __builtin_amdgcn_fence(__ATOMIC_ACQUIRE, "agent");
      xb_add(&bar[XB_XGEN(b.x)], 1u);
      asm volatile("s_waitcnt vmcnt(0)" ::: "memory");
    } else {
      XB_SPIN(xb_ld(&bar[XB_XGEN(b.x)]) == gen, bar);
      __builtin_amdgcn_fence(__ATOMIC_ACQUIRE, "agent");
      asm volatile("s_waitcnt vmcnt(0)" ::: "memory");
    }
  }
  __syncthreads();
}

constexpr int NSUB = 10, NPH = 1 + 2 * NSUB;
template <bool WITH_P0>
__device__ __forceinline__ void run_phase(const P& pin, int ph, char* lds) {
  typedef const __attribute__((address_space(4))) P* KP;
  KP kp = (KP)__builtin_amdgcn_kernarg_segment_ptr();
  asm volatile("" : "+s"(kp));
  P p;
  p.x = kp->x;
  p.p = kp->p;
  p.pos = kp->pos;
  p.w_in = kp->w_in;
  p.lq1 = kp->lq1;
  p.lk1 = kp->lk1;
  p.lq2 = kp->lq2;
  p.lk2 = kp->lk2;
  p.subln = kp->subln;
  p.gn_g = kp->gn_g;
  p.gn_b = kp->gn_b;
  p.A_re = kp->A_re;
  p.A_im = kp->A_im;
  p.log_dt = kp->log_dt;
  p.B_re = kp->B_re;
  p.B_im = kp->B_im;
  p.C_re = kp->C_re;
  p.C_im = kp->C_im;
  p.Dp = kp->Dp;
  p.glu_w = kp->glu_w;
  p.glu_b = kp->glu_b;
  p.w_out = kp->w_out;
  p.ln1g = kp->ln1g;
  p.ln1b = kp->ln1b;
  p.w_up = kp->w_up;
  p.conv_w = kp->conv_w;
  p.conv_b = kp->conv_b;
  p.w_down = kp->w_down;
  p.ple_w = kp->ple_w;
  p.gate_w = kp->gate_w;
  p.ln2g = kp->ln2g;
  p.ln2b = kp->ln2b;
  p.out = kp->out;
  p.ws = kp->ws;

  if (ph == 0) { if (WITH_P0) phase0(p, lds); return; }
  const int layer = (ph - 1) / NSUB, s = (ph - 1) % NSUB;
  const int bid = blockIdx.x, nb = gridDim.x;
  switch (s) {
    case 0: phase_z(p, layer, lds); if (layer == 0) s5_build_ktab_F(p); break;
    case 1:
      for (int t = bid; t < 1024; t += nb) ret_kv_item(p, t, lds);
      for (int t = bid; t < 256; t += nb) s5_state_tile(p, layer, t, lds);
      if (layer == 0) s5_build_M(p);
      break;
    case 2: s5_scan(p, layer); ret_scan(p); break;
    case 3: {
      const int x = bid & 7, lb = bid >> 3, nlb = nb >> 3;
      for (int t = bid; t < 1024; t += nb) ret_out_item(p, layer, t, lds);
      for (int t = bid; t < 512; t += nb) s5_out_tile(p, layer, t, lds);
      for (int i = lb; i < 128; i += nlb) attn_item(p, layer, (i >> 6) * 512 + x * 64 + (i & 63), lds);
    } break;
    case 4: phase_glu(p, layer, lds); break;
    case 5: phase_wout(p, layer, lds); break;
    case 6: phase_ln(p, p.ln1g + layer * DM, p.ln1b + layer * DM, p.p + (size_t)layer * TT * 256, false, (const _Float16*)(p.ws + OFF_PRE1)); break;
    case 7: phase_ffn_up(p, layer, lds); break;
    case 8: phase_ffn_down(p, layer, lds); break;
    default: phase_ln(p, p.ln2g + layer * DM, p.ln2b + layer * DM, nullptr, layer == 1, (const _Float16*)(p.ws + OFF_PRE2)); break;
  }
}

__global__ void __launch_bounds__(NTHR, 2) mega(P p, int ph0, int ph1) {
  extern __shared__ __attribute__((aligned(16))) char lds[];
  if (ph1 < 0) cg::this_grid().sync();
  volatile LAS unsigned* st = (volatile LAS unsigned*)(lds + LDS_BYTES);
  if (threadIdx.x == 0) { st[0] = 0u; st[1] = 0u; st[2] = 0u; st[3] = 0u; }
  __syncthreads();
  const XcdBarrier xb = xcd_barrier_post((unsigned*)(p.ws + OFF_BAR), st);
#define GSYNC() xcd_barrier(xb)
  for (int i = 0; i < PROBE_SYNCS; ++i) GSYNC();
  int ph = ph0;
  if (ph == 0) {
    const int nrep0 = 1 + ((PROBE_MASK >> NSUB) & 1);
    for (int rep = 0; rep < nrep0; ++rep) { run_phase<true>(p, 0, lds); if (rep + 1 < nrep0 || 1 < ph1) GSYNC(); }
    ph = 1;
  }
  for (; ph < ph1; ++ph) {
    const int nrep = 1 + ((PROBE_MASK >> ((ph - 1) % NSUB)) & 1);
    for (int rep = 0; rep < nrep; ++rep) {
      run_phase<false>(p, ph, lds);
      if (rep + 1 < nrep || ph + 1 < ph1) GSYNC();
    }
  }
#undef GSYNC
}

extern "C" void kernel_launch(void* const* d_in, const int* in_sizes, int n_in, void* d_out, int out_size,
                              void* d_ws, size_t ws_size, hipStream_t stream) {
  static int grid_blocks = 0;
  if (!grid_blocks) {
    int dev = 0, cus = 0, per_cu = 0;
    (void)hipGetDevice(&dev);
    (void)hipDeviceGetAttribute(&cus, hipDeviceAttributeMultiprocessorCount, dev);
    (void)hipFuncSetAttribute((const void*)mega, hipFuncAttributeMaxDynamicSharedMemorySize, LDS_TOTAL);
    (void)hipOccupancyMaxActiveBlocksPerMultiprocessor(&per_cu, mega, NTHR, LDS_TOTAL);
    if (per_cu > 2) per_cu = 2;
    if (per_cu < 1) per_cu = 1;
    grid_blocks = cus * per_cu;
    grid_blocks -= grid_blocks % 8;
    if (ws_size < WS_NEED) fprintf(stderr, "kernel_launch: workspace too small: %zu < %zu\n", ws_size, WS_NEED);
  }
  if (ws_size < WS_NEED || n_in < 32) return;
  P p{};
  p.x = (const float*)d_in[0]; p.p = (const float*)d_in[1]; p.pos = (const int*)d_in[2];
  p.w_in = (const float*)d_in[3]; p.lq1 = (const float*)d_in[4]; p.lk1 = (const float*)d_in[5]; p.lq2 = (const float*)d_in[6];
  p.lk2 = (const float*)d_in[7]; p.subln = (const float*)d_in[8]; p.gn_g = (const float*)d_in[9]; p.gn_b = (const float*)d_in[10];
  p.A_re = (const float*)d_in[11]; p.A_im = (const float*)d_in[12]; p.log_dt = (const float*)d_in[13]; p.B_re = (const float*)d_in[14];
  p.B_im = (const float*)d_in[15]; p.C_re = (const float*)d_in[16]; p.C_im = (const float*)d_in[17]; p.Dp = (const float*)d_in[18];
  p.glu_w = (const float*)d_in[19]; p.glu_b = (const float*)d_in[20]; p.w_out = (const float*)d_in[21]; p.ln1g = (const float*)d_in[22];
  p.ln1b = (const float*)d_in[23]; p.w_up = (const float*)d_in[24]; p.conv_w = (const float*)d_in[25]; p.conv_b = (const float*)d_in[26];
  p.w_down = (const float*)d_in[27]; p.ple_w = (const float*)d_in[28]; p.gate_w = (const float*)d_in[29]; p.ln2g = (const float*)d_in[30];
  p.ln2b = (const float*)d_in[31];
  p.out = (float*)d_out; p.ws = (char*)d_ws;
#if MK_LAUNCHES == 1
  int ph0 = 0, ph1 = NPH;
  void* args[] = {&p, &ph0, &ph1};
  (void)hipMemsetAsync((char*)d_ws + OFF_BAR, 0, SZ_BAR, stream);
  hipError_t e = hipLaunchCooperativeKernel((void*)mega, dim3(grid_blocks), dim3(NTHR), args, LDS_TOTAL, stream);
  if (e != hipSuccess) fprintf(stderr, "cooperative launch failed: %s (grid %d)\n", hipGetErrorString(e), grid_blocks);
#else
  for (int ph = 0; ph < NPH; ++ph) hipLaunchKernelGGL(mega, dim3(grid_blocks), dim3(NTHR), LDS_TOTAL, stream, p, ph, ph + 1);
#endif
}
```
